# Optimizing an MI355X kernel written in HIP

```python
import math
import jax, jax.numpy as jnp
from jax import lax
import numpy as np

D_MODEL = 2048
BATCH = 2
SEQ = 16384
DEPTH = 1

ATTN_HEAD_DIM = 64
ATTN_WIDTH = D_MODEL // 2
ATTN_HEADS = ATTN_WIDTH // ATTN_HEAD_DIM
ATTN_KV_HEADS = ATTN_HEADS // 4
ATTN_GROUP = ATTN_HEADS // ATTN_KV_HEADS
ATTN_KV_COLS = ATTN_KV_HEADS * ATTN_HEAD_DIM
WINDOW = 128
BLOCK = 128
HALO = -(-WINDOW // BLOCK)
N_BUCKETS = 32
MAX_DISTANCE = 128

RET_WIDTH = D_MODEL - ATTN_WIDTH
RET_HEADS = 8
RET_VAL_DIM = RET_WIDTH // RET_HEADS
RET_KEY_DIM = RET_VAL_DIM // 2
RET_QK_COLS = RET_HEADS * RET_KEY_DIM
CHUNK = 128
ROPE_BASE = 10000.0

MIX_WIDTH = ATTN_WIDTH + RET_WIDTH
SPLIT_SIZES = (ATTN_WIDTH, ATTN_KV_COLS, ATTN_KV_COLS, ATTN_WIDTH,
               RET_QK_COLS, RET_QK_COLS, RET_WIDTH, RET_WIDTH)
IN_WIDTH = sum(SPLIT_SIZES)
EPS = 1e-6

kernel_name = 'hymba_swa_retention_block'


def rmsnorm(x, w):
    x32 = x.astype(jnp.float32)
    x32 = x32 * lax.rsqrt(jnp.mean(x32 * x32, axis=-1, keepdims=True) + EPS)
    return x32.astype(x.dtype) * w


def t5_bucket(rel):
    nb = N_BUCKETS // 2
    max_exact = nb // 2
    ret = jnp.where(rel > 0, nb, 0)
    n = jnp.abs(rel)
    nf = jnp.maximum(n, 1).astype(jnp.float32)
    large = max_exact + (jnp.log(nf / max_exact) / math.log(MAX_DISTANCE / max_exact)
                         * (nb - max_exact)).astype(jnp.int32)
    large = jnp.minimum(large, nb - 1)
    return ret + jnp.where(n < max_exact, n, large)


def windowed_attention(q, k, v, sink, rel_bias):
    B, S = q.shape[0], q.shape[1]
    nb = S // BLOCK
    KW = (2 * HALO + 1) * BLOCK
    qb = q.reshape(B, nb, BLOCK, ATTN_KV_HEADS, ATTN_GROUP, ATTN_HEAD_DIM)
    pad = ((0, 0), (HALO * BLOCK, HALO * BLOCK), (0, 0), (0, 0))
    kp = jnp.pad(k, pad).reshape(B, nb + 2 * HALO, BLOCK, ATTN_KV_HEADS, ATTN_HEAD_DIM)
    vp = jnp.pad(v, pad).reshape(B, nb + 2 * HALO, BLOCK, ATTN_KV_HEADS, ATTN_HEAD_DIM)
    kb = jnp.concatenate([kp[:, o:o + nb] for o in range(2 * HALO + 1)], axis=2)
    vb = jnp.concatenate([vp[:, o:o + nb] for o in range(2 * HALO + 1)], axis=2)

    scale = ATTN_HEAD_DIM ** -0.5
    s = jnp.einsum('bnqhgd,bnkhd->bhgnqk', qb, kb).astype(jnp.float32) * scale

    qi = jnp.arange(BLOCK, dtype=jnp.int32)[:, None]
    kt = jnp.arange(KW, dtype=jnp.int32)[None, :]
    rel = kt - HALO * BLOCK - qi
    bias = rel_bias.astype(jnp.float32)[t5_bucket(rel)]
    bias = jnp.moveaxis(bias, -1, 0).reshape(ATTN_KV_HEADS, ATTN_GROUP, 1, BLOCK, KW)
    key_pos = (jnp.arange(nb, dtype=jnp.int32)[:, None, None] * BLOCK
               + kt[None] - HALO * BLOCK)
    valid = (jnp.abs(rel)[None] <= WINDOW) & (key_pos >= 0) & (key_pos < S)
    s = jnp.where(valid[None, None, None], s + bias[None], -1e30)

    sink_b = sink.astype(jnp.float32).reshape(1, ATTN_KV_HEADS, ATTN_GROUP, 1, 1, 1)
    m = jnp.maximum(jnp.max(s, axis=-1, keepdims=True), sink_b)
    p = jnp.exp(s - m)
    p = p / (jnp.sum(p, axis=-1, keepdims=True) + jnp.exp(sink_b - m))
    out = jnp.einsum('bhgnqk,bnkhd->bnqhgd', p.astype(v.dtype), vb)
    return out.reshape(B, S, ATTN_WIDTH)


def rotary(x):
    S, D = x.shape[1], x.shape[-1]
    inv = ROPE_BASE ** (-jnp.arange(0, D, 2, dtype=jnp.float32) / D)
    ang = jnp.arange(S, dtype=jnp.float32)[:, None] * inv[None, :]
    cos = jnp.cos(ang)[None, :, None, :]
    sin = jnp.sin(ang)[None, :, None, :]
    xr = x.astype(jnp.float32).reshape(x.shape[:-1] + (D // 2, 2))
    x1, x2 = xr[..., 0], xr[..., 1]
    return jnp.stack([x1 * cos - x2 * sin, x1 * sin + x2 * cos], axis=-1).reshape(x.shape)


def retention_chunkwise(q, k, v, log_gamma, strict):
    B, S, H, Dk = q.shape
    Dv = v.shape[-1]
    nc = S // CHUNK
    qc = q.reshape(B, nc, CHUNK, H, Dk)
    kc = k.reshape(B, nc, CHUNK, H, Dk)
    vc = v.reshape(B, nc, CHUNK, H, Dv)
    idx = jnp.arange(CHUNK, dtype=jnp.float32)
    diff = idx[:, None] - idx[None, :]
    keep = diff > 0 if strict else diff >= 0
    dmask = jnp.where(keep[None], jnp.exp(log_gamma[:, None, None] * jnp.maximum(diff, 0.0)[None]), 0.0)
    s = jnp.einsum('bnihd,bnjhd->bhnij', qc, kc) * dmask[None, :, None]
    intra = jnp.einsum('bhnij,bnjhe->bnihe', s, vc)
    kdec = jnp.exp(log_gamma[None, :] * (CHUNK - 1 - idx)[:, None])
    kv = jnp.einsum('bnjhd,bnjhe->nbhde', kc * kdec[None, None, :, :, None], vc)
    chunk_decay = jnp.exp(log_gamma * CHUNK)[None, :, None, None]

    def step(state, kv_c):
        return state * chunk_decay + kv_c, state

    _, prev = lax.scan(step, jnp.zeros((B, H, Dk, Dv), jnp.float32), kv)
    qdec = jnp.exp(log_gamma[None, :] * (idx + 1.0)[:, None])
    cross = jnp.einsum('bnihd,nbhde->bnihe', qc * qdec[None, None, :, :, None], prev)
    return (intra + cross).reshape(B, S, H, Dv)


def bidirectional_retention(q, k, v, decay_fwd, decay_bwd):
    lg_f = jax.nn.log_sigmoid(decay_fwd.astype(jnp.float32))
    lg_b = jax.nn.log_sigmoid(decay_bwd.astype(jnp.float32))
    fwd = retention_chunkwise(q, k, v, lg_f, strict=False)
    flip = lambda t: jnp.flip(t, axis=1)
    bwd = flip(retention_chunkwise(flip(q), flip(k), flip(v), lg_b, strict=True))
    return fwd + bwd


def head_groupnorm(o, w):
    mu = jnp.mean(o, axis=-1, keepdims=True)
    var = jnp.mean((o - mu) ** 2, axis=-1, keepdims=True)
    o = (o - mu) * lax.rsqrt(var + EPS)
    return o.reshape(o.shape[0], o.shape[1], -1) * w.astype(jnp.float32)


def setup_inputs(seed: int = 0) -> dict:
    key = jax.random.key(seed)
    ks = jax.random.split(key, 12)
    f32 = jnp.float32
    x = jax.random.normal(ks[0], (BATCH, SEQ, D_MODEL), f32)
    norm_w = 1.0 + 0.02 * jax.random.normal(ks[1], (DEPTH, D_MODEL), f32)
    w_in = jax.random.normal(ks[2], (DEPTH, D_MODEL, IN_WIDTH), f32) * D_MODEL ** -0.5
    attn_sink = 0.5 * jax.random.normal(ks[3], (DEPTH, ATTN_HEADS), f32)
    rel_bias = 0.1 * jax.random.normal(ks[4], (N_BUCKETS, ATTN_HEADS), f32)
    attn_out_norm_w = 1.0 + 0.02 * jax.random.normal(ks[5], (DEPTH, ATTN_WIDTH), f32)
    scales = jnp.log(2.0 ** (5.0 + jnp.arange(RET_HEADS, dtype=f32)) - 1.0)
    ret_decay_fwd = scales[None] + 0.05 * jax.random.normal(ks[6], (DEPTH, RET_HEADS), f32)
    ret_decay_bwd = scales[None] + 0.05 * jax.random.normal(ks[7], (DEPTH, RET_HEADS), f32)
    ret_gn_w = 1.0 + 0.02 * jax.random.normal(ks[8], (DEPTH, RET_WIDTH), f32)
    w_out = jax.random.normal(ks[9], (DEPTH, MIX_WIDTH, D_MODEL), f32) * MIX_WIDTH ** -0.5
    final_norm_w = 1.0 + 0.02 * jax.random.normal(ks[10], (D_MODEL,), f32)
    return {'x': x, 'norm_w': norm_w, 'w_in': w_in, 'attn_sink': attn_sink,
            'rel_bias': rel_bias, 'attn_out_norm_w': attn_out_norm_w,
            'ret_decay_fwd': ret_decay_fwd, 'ret_decay_bwd': ret_decay_bwd,
            'ret_gn_w': ret_gn_w, 'w_out': w_out, 'final_norm_w': final_norm_w}


def reference(x, norm_w, w_in, attn_sink, rel_bias, attn_out_norm_w,
              ret_decay_fwd, ret_decay_bwd, ret_gn_w, w_out, final_norm_w):
    B, S = x.shape[0], x.shape[1]
    points = [int(p) for p in np.cumsum(SPLIT_SIZES)[:-1]]
    for l in range(DEPTH):
        h = rmsnorm(x, norm_w[l])
        proj = jnp.einsum('bsd,de->bse', h, w_in[l])
        q_a, k_a, v_a, g_a, q_r, k_r, v_r, g_r = jnp.split(proj, points, axis=-1)

        attn = windowed_attention(q_a.reshape(B, S, ATTN_HEADS, ATTN_HEAD_DIM),
                                  k_a.reshape(B, S, ATTN_KV_HEADS, ATTN_HEAD_DIM),
                                  v_a.reshape(B, S, ATTN_KV_HEADS, ATTN_HEAD_DIM),
                                  attn_sink[l], rel_bias)
        attn = rmsnorm(attn, attn_out_norm_w[l]) * jax.nn.silu(g_a)

        qr = rotary(q_r.reshape(B, S, RET_HEADS, RET_KEY_DIM))
        kr = rotary(k_r.reshape(B, S, RET_HEADS, RET_KEY_DIM)) * RET_KEY_DIM ** -0.5
        vr = v_r.reshape(B, S, RET_HEADS, RET_VAL_DIM).astype(jnp.float32)
        ret = bidirectional_retention(qr, kr, vr, ret_decay_fwd[l], ret_decay_bwd[l])
        ret = head_groupnorm(ret, ret_gn_w[l]).astype(x.dtype) * jax.nn.silu(g_r)

        mixed = jnp.concatenate([attn.astype(x.dtype), ret], axis=-1)
        x = x + jnp.einsum('bse,ed->bsd', mixed, w_out[l])
    return rmsnorm(x, final_norm_w)
```

```cpp
#include <hip/hip_runtime.h>
#include <cstdio>
#include <cstdint>
namespace pg8 {
#define PG8_LAS __attribute__((address_space(3)))
typedef unsigned short bf16_t;
typedef short bf16x8 __attribute__((ext_vector_type(8)));
typedef float f32x4 __attribute__((ext_vector_type(4)));
typedef unsigned u32x4 __attribute__((ext_vector_type(4)));
constexpr int BM = 256, BK = 64, HALF = 128, HTB = HALF * BK * 2  , STAGE_BYTES = 8 * HTB, NXCD = 8, WGM = 8;

__host__ __device__ __forceinline__ int lds_byte(int r, int c) { const int st = (r >> 4) * 2 + (c >> 5), rr = r & 15, cc = c & 31, ob = rr * 64 + cc * 2; return st * 1024 + (ob ^ (((ob >> 9) & 1) << 5)); }
__host__ __device__ __forceinline__ void stage_rc(int b, int& R, int& C) { const int st = b / 1024, sb = b % 1024, swz = sb ^ (((sb >> 9) & 1) << 5); R = (st >> 1) * 16 + swz / 64; C = (st & 1) * 32 + (swz % 64) / 2; }
__host__ __device__ __forceinline__ int perm32(int rho) { const int n = rho >> 4, i = rho & 15; return 8 * (i >> 2) + 4 * n + (i & 3); }

struct Unit { int pm, pn; };
struct Gemm { const bf16_t* A; const bf16_t* Bt; int M, N, K; };

struct StaticOrder {
    int nM, nN, nwg, G, c;
    __host__ __device__ void init(int M, int N, int G_, int c_) { nM = M / BM; nN = N / BM; nwg = nM * nN; G = G_; c = c_; }
    __host__ __device__ bool next(int i, Unit& u) const {
        const long L = (long)i * G + c; if (L >= nwg) return false;
        int wgid = (int)L; { const int q = nwg / NXCD, r = nwg % NXCD, xcd = wgid % NXCD, off = wgid / NXCD; wgid = (xcd < r ? xcd * (q + 1) : r * (q + 1) + (xcd - r) * q) + off; }
        const int nig = WGM * nN, gid = wgid / nig, fm = gid * WGM, gsz = (nM - fm) < WGM ? (nM - fm) : WGM;
        u.pm = fm + ((wgid % nig) % gsz); u.pn = (wgid % nig) / gsz; return true;
    }
    __device__ __forceinline__ void a_ready(const Unit&) const {}
    __device__ __forceinline__ void done(const Unit&) const {}
};

__device__ __forceinline__ unsigned cvt_pk_bf16(float lo, float hi) { unsigned r; asm volatile("v_cvt_pk_bf16_f32 %0, %1, %2" : "=v"(r) : "v"(lo), "v"(hi)); return r; }
typedef float f32x2 __attribute__((ext_vector_type(2)));
template <class Epi, class Sched, bool ALIGN_EPI = false, bool SP2 = false>
__device__ __forceinline__ void gemm_phase(PG8_LAS unsigned char* lds, const Gemm g, const Sched& S, const Epi& E) {
    const int tid = threadIdx.x, wid = __builtin_amdgcn_readfirstlane(tid >> 6), lane = tid & 63, wr = wid >> 2, wc = wid & 3, fr = lane & 15, fq = lane >> 4;
    const int K = g.K, nt = K / BK;
    unsigned voffA[2], voffB[2];
#pragma unroll
    for (int i = 0; i < 2; ++i) { int R, C; stage_rc(tid * 16 + i * 8192, R, C); const int Rb = Epi::PERM ? ((R & ~31) + perm32(R & 31)) : R;
        voffA[i] = (unsigned)(R * K + C) * 2u; voffB[i] = (unsigned)(Rb * K + C) * 2u; }
    const size_t kstep = (size_t)(BK * 2);
    const size_t hstep = (size_t)HALF * K * 2;
    const size_t tstep = 2 * hstep;
    const unsigned ldsw = (unsigned)wid * 1024u;
    const int aoff = lds_byte(wr * 64 + fr, fq * 8), boff = lds_byte(wc * 32 + fr, fq * 8);
#define PG8_SA(b, h) (((b) * 2 + (h)) * HTB)
#define PG8_SB(b, h) ((4 + (b) * 2 + (h)) * HTB)
#define PG8_STAGE(bufoff, gbase, voff) do { _Pragma("unroll") for (int _i = 0; _i < 2; ++_i) \
        __builtin_amdgcn_global_load_lds((const unsigned*)((const char*)(gbase) + (voff)[_i]), (PG8_LAS unsigned*)(lds + (bufoff) + ldsw + _i * 8192), 16, 0, 0); } while (0)
#define PG8_LDA(dst, b, h) do { _Pragma("unroll") for (int m = 0; m < 4; ++m) _Pragma("unroll") for (int k = 0; k < 2; ++k) dst[m][k] = *(const PG8_LAS bf16x8*)(lds + PG8_SA(b, h) + aoff + m * 2048 + k * 1024); } while (0)
#define PG8_LDB(dst, b, h) do { _Pragma("unroll") for (int n = 0; n < 2; ++n) _Pragma("unroll") for (int k = 0; k < 2; ++k) dst[n][k] = *(const PG8_LAS bf16x8*)(lds + PG8_SB(b, h) + boff + n * 2048 + k * 1024); } while (0)
#define PG8_MMA(ai, bj, At, Bt) do { __builtin_amdgcn_s_setprio(1); _Pragma("unroll") for (int m = 0; m < 4; ++m) _Pragma("unroll") for (int n = 0; n < 2; ++n) _Pragma("unroll") for (int k = 0; k < 2; ++k) \
        acc[ai][bj][m][n] = __builtin_amdgcn_mfma_f32_16x16x32_bf16(Bt[n][k], At[m][k], acc[ai][bj][m][n], 0, 0, 0); __builtin_amdgcn_s_setprio(0); } while (0)
#define PG8_WAIT_V(n) asm volatile("s_waitcnt vmcnt(" #n ")" ::: "memory")
#define PG8_WAIT_L(n) asm volatile("s_waitcnt lgkmcnt(" #n ")" ::: "memory")
#define PG8_BAR __builtin_amdgcn_s_barrier()
#define PG8_SCHED __builtin_amdgcn_sched_barrier(0)
    Unit cur, nxt; int ui = 0;
    if (!S.next(0, cur)) return;
    f32x4 acc[2][2][4][2];
#pragma unroll
    for (int a = 0; a < 2; ++a)
#pragma unroll
        for (int b = 0; b < 2; ++b)
#pragma unroll
            for (int m = 0; m < 4; ++m)
#pragma unroll
                for (int n = 0; n < 2; ++n) acc[a][b][m][n] = (f32x4){0.f, 0.f, 0.f, 0.f};
    bf16x8 At[4][2], B0[2][2], B1[2][2];
    const char* cA = (const char*)g.A + (size_t)cur.pm * tstep; const char* cB = (const char*)g.Bt + (size_t)cur.pn * tstep;
    S.a_ready(cur);
    if constexpr (SP2) {
        PG8_STAGE(PG8_SB(0, 0), cB, voffB); PG8_STAGE(PG8_SB(0, 1), cB + hstep, voffB); PG8_STAGE(PG8_SA(0, 0), cA, voffA); PG8_STAGE(PG8_SA(0, 1), cA + hstep, voffA);
        if (wr == 1) PG8_BAR;
        PG8_WAIT_V(2); PG8_BAR;
        PG8_STAGE(PG8_SB(1, 0), cB + kstep, voffB); PG8_STAGE(PG8_SA(1, 0), cA + kstep, voffA); PG8_STAGE(PG8_SB(1, 1), cB + hstep + kstep, voffB);
        PG8_WAIT_V(6); PG8_BAR;
    } else {
        PG8_STAGE(PG8_SB(0, 0), cB, voffB); PG8_STAGE(PG8_SA(0, 0), cA, voffA); PG8_STAGE(PG8_SB(0, 1), cB + hstep, voffB); PG8_STAGE(PG8_SA(0, 1), cA + hstep, voffA);
        if (wr == 1) PG8_BAR;
        PG8_WAIT_V(4); PG8_BAR;
        PG8_STAGE(PG8_SB(1, 0), cB + kstep, voffB); PG8_STAGE(PG8_SA(1, 0), cA + kstep, voffA); PG8_STAGE(PG8_SB(1, 1), cB + hstep + kstep, voffB);
        PG8_WAIT_V(6); PG8_BAR;
    }
    for (;;) {
        const bool has_next = S.next(ui + 1, nxt);
        const char* nA = has_next ? (const char*)g.A + (size_t)nxt.pm * tstep : cA; const char* nB = has_next ? (const char*)g.Bt + (size_t)nxt.pn * tstep : cB;
        for (int t = 0; t < nt; t += 2) {
            const bool last = (t == nt - 2);
            const char* a1 = cA + (size_t)(t + 1) * kstep;
            const char* a2 = last ? nA : cA + (size_t)(t + 2) * kstep; const char* b2 = last ? nB : cB + (size_t)(t + 2) * kstep;
            const char* a3 = a2 + kstep; const char* b3 = b2 + kstep;
            if (last && has_next) S.a_ready(nxt);
            if constexpr (SP2) {
            PG8_LDB(B0, 0, 0); PG8_LDB(B1, 0, 1); PG8_SCHED; PG8_LDA(At, 0, 0); PG8_STAGE(PG8_SA(1, 1), a1 + hstep, voffA);
            PG8_WAIT_V(8); PG8_WAIT_L(0); PG8_BAR; PG8_MMA(0, 0, At, B0); PG8_MMA(0, 1, At, B1); PG8_BAR; PG8_SCHED;
            PG8_LDA(At, 0, 1); PG8_STAGE(PG8_SB(0, 0), b2, voffB); PG8_STAGE(PG8_SB(0, 1), b2 + hstep, voffB); PG8_STAGE(PG8_SA(0, 0), a2, voffA);
            PG8_WAIT_V(8); PG8_WAIT_L(0); PG8_BAR; PG8_MMA(1, 0, At, B0); PG8_MMA(1, 1, At, B1); PG8_BAR; PG8_SCHED;
            PG8_LDB(B0, 1, 0); PG8_LDB(B1, 1, 1); PG8_SCHED; PG8_LDA(At, 1, 0); PG8_STAGE(PG8_SA(0, 1), a2 + hstep, voffA);
            PG8_WAIT_V(8); PG8_WAIT_L(0); PG8_BAR; PG8_MMA(0, 0, At, B0); PG8_MMA(0, 1, At, B1); PG8_BAR; PG8_SCHED;
            PG8_LDA(At, 1, 1); PG8_STAGE(PG8_SB(1, 0), b3, voffB); PG8_STAGE(PG8_SB(1, 1), b3 + hstep, voffB); PG8_STAGE(PG8_SA(1, 0), a3, voffA);
            PG8_WAIT_V(8); PG8_WAIT_L(0); PG8_BAR; PG8_MMA(1, 0, At, B0); PG8_MMA(1, 1, At, B1); PG8_BAR; PG8_SCHED;
            } else {
            PG8_LDB(B0, 0, 0); PG8_SCHED; PG8_LDA(At, 0, 0); PG8_STAGE(PG8_SA(1, 1), a1 + hstep, voffA);
            PG8_WAIT_L(8); PG8_BAR; PG8_WAIT_L(0); PG8_MMA(0, 0, At, B0); PG8_BAR; PG8_SCHED;
            PG8_LDB(B1, 0, 1); PG8_STAGE(PG8_SB(0, 0), b2, voffB);
            PG8_BAR; PG8_WAIT_L(0); PG8_MMA(0, 1, At, B1); PG8_BAR;
            PG8_LDA(At, 0, 1); PG8_STAGE(PG8_SA(0, 0), a2, voffA);
            PG8_BAR; PG8_WAIT_L(0); PG8_MMA(1, 0, At, B0); PG8_BAR; PG8_SCHED;
            PG8_STAGE(PG8_SB(0, 1), b2 + hstep, voffB);
            PG8_WAIT_V(6); PG8_BAR; PG8_MMA(1, 1, At, B1); PG8_BAR;
            PG8_LDB(B0, 1, 0); PG8_SCHED; PG8_LDA(At, 1, 0); PG8_STAGE(PG8_SA(0, 1), a2 + hstep, voffA);
            PG8_WAIT_L(8); PG8_BAR; PG8_WAIT_L(0); PG8_MMA(0, 0, At, B0); PG8_BAR; PG8_SCHED;
            PG8_LDB(B1, 1, 1); PG8_STAGE(PG8_SB(1, 0), b3, voffB);
            PG8_BAR; PG8_WAIT_L(0); PG8_MMA(0, 1, At, B1); PG8_BAR;
            PG8_LDA(At, 1, 1); PG8_STAGE(PG8_SA(1, 0), a3, voffA);
            PG8_BAR; PG8_WAIT_L(0); PG8_MMA(1, 0, At, B0); PG8_BAR; PG8_SCHED;
            PG8_STAGE(PG8_SB(1, 1), b3 + hstep, voffB);
            PG8_WAIT_V(6); PG8_BAR; PG8_MMA(1, 1, At, B1); PG8_BAR;
            }
        }
        if constexpr (ALIGN_EPI) { if (wr == 0) PG8_BAR; }
        if constexpr (!Epi::AFTER_DRAIN) { E(acc, cur, wr, wc, fr, fq); S.done(cur); }
        if (!has_next) break;
#pragma unroll
        for (int a = 0; a < 2; ++a)
#pragma unroll
            for (int b = 0; b < 2; ++b)
#pragma unroll
                for (int m = 0; m < 4; ++m)
#pragma unroll
                    for (int n = 0; n < 2; ++n) acc[a][b][m][n] = (f32x4){0.f, 0.f, 0.f, 0.f};
        cur = nxt; cA = nA; cB = nB; ++ui;
        if constexpr (ALIGN_EPI) { if (wr == 1) PG8_BAR; }
    }
    PG8_WAIT_V(0);
    if constexpr (!ALIGN_EPI) { if (wr == 0) PG8_BAR; }
    PG8_BAR;
    if constexpr (Epi::AFTER_DRAIN) { E.fused(acc, cur, wr, wc, fr, fq, lds, wid, lane); S.done(cur); }
#undef PG8_SA
#undef PG8_SB
#undef PG8_STAGE
#undef PG8_LDA
#undef PG8_LDB
#undef PG8_MMA
#undef PG8_WAIT_V
#undef PG8_WAIT_L
#undef PG8_BAR
#undef PG8_SCHED
}
}
#define GAS __attribute__((address_space(1)))
#define LAS __attribute__((address_space(3)))
typedef unsigned short bf16;
typedef unsigned v4u __attribute__((ext_vector_type(4)));
typedef float f32x4 __attribute__((ext_vector_type(4)));
typedef short bf16x8 __attribute__((ext_vector_type(8)));
typedef GAS unsigned gu32;
typedef GAS unsigned long long gu64;
#define RLX_AGENT __ATOMIC_RELAXED, __HIP_MEMORY_SCOPE_AGENT
#define LDS_WAIT() asm volatile("s_waitcnt lgkmcnt(0)" ::: "memory")
#define VM_WAIT() asm volatile("s_waitcnt vmcnt(0)" ::: "memory")
__device__ __forceinline__ unsigned long long rt() { return __builtin_amdgcn_s_memrealtime(); }
__device__ __forceinline__ unsigned f2bf(float f) { unsigned u = __builtin_bit_cast(unsigned, f); return (u + 0x7fffu + ((u >> 16) & 1u)) >> 16; }
__device__ __forceinline__ unsigned pk2(float lo, float hi) { return f2bf(lo) | (f2bf(hi) << 16); }

constexpr int NB = 2, SEQ = 16384, T = NB * SEQ, DM = 2048, INW = 5632;
constexpr int AH = 16, AHD = 64, AW = 1024, AKW = 256;
constexpr int RH = 8, RDK = 64, RDV = 128, RQW = 512, RW = 1024, CH = 128, NC = SEQ / CH;
constexpr float EPS = 1e-6f, LOG2E = 1.4426950408889634f;
constexpr int BIAS_LD = 260;
constexpr int NWAVES = 8;

constexpr size_t MiB = 1u << 20;
constexpr size_t WS_CTL = 0, CTL_ZERO_BYTES = 1 * MiB;
constexpr size_t WS_COS = 1 * MiB, WS_SIN = 3 * MiB;
constexpr size_t WS_DEC = 5 * MiB;
constexpr size_t WS_BIAS = 5 * MiB + 65536;
constexpr size_t WS_SINK = 5 * MiB + 131072;
constexpr size_t WS_GAM = 5 * MiB + 131072 + 256;
constexpr size_t WS_WIN = 8 * MiB;
constexpr size_t WS_WO = 30 * MiB;
constexpr size_t WS_XN = 40 * MiB;
constexpr size_t WS_MIX = WS_XN;
constexpr size_t WS_QA = 168 * MiB, WS_KA = 232 * MiB, WS_VA = 248 * MiB, WS_GA = 264 * MiB;
constexpr size_t WS_QF = 328 * MiB, WS_QB = 360 * MiB, WS_KF = 392 * MiB, WS_KB = 424 * MiB, WS_VR = 456 * MiB, WS_GR = 520 * MiB;
constexpr size_t WS_AR = 584 * MiB;
constexpr size_t WS_SSQ = 648 * MiB;
constexpr size_t WS_G = 652 * MiB;
constexpr size_t WS_ST = 780 * MiB;
constexpr size_t WS_YSSQ = 844 * MiB;
constexpr size_t WS_END = 848 * MiB;
constexpr int CW_TMO = 0, CW_CODE = 1, CW_BAR = 4096;

constexpr int RING_OFF = 0, RING_BYTES = 131072;
constexpr int LDSCTL_OFF = RING_BYTES, MISC_OFF = LDSCTL_OFF + 320;
constexpr int LDS_BYTES = 147456;
#define XB_TMO      128
#define XB_XCNT(j)  (256  + 64 * (j))
#define XB_XSUB(j)  (1280 + 64 * (j))
#define XB_XGEN(j)  (2304 + 64 * (j))
#define XB_TOP      3328
#define XB_TOPGEN   3392
#define XCD_BAR_WORDS 3456
#define XB_SPIN_CAP (1u << 24)

__device__ __forceinline__ unsigned xb_ld(unsigned* p)              { return __hip_atomic_load(p, __ATOMIC_RELAXED, __HIP_MEMORY_SCOPE_AGENT); }
__device__ __forceinline__ unsigned xb_add(unsigned* p, unsigned v) { return __hip_atomic_fetch_add(p, v, __ATOMIC_RELAXED, __HIP_MEMORY_SCOPE_AGENT); }
__device__ __forceinline__ unsigned xb_xcc_id() { return (unsigned)__builtin_amdgcn_s_getreg((3 << 11) | 20) & 0xFu; }
#define XB_SPIN(cond, bar) do { unsigned _sp = 0; while (cond) { __builtin_amdgcn_s_sleep(1); \
    if ((++_sp & 255u) == 0u) { if (xb_ld(&(bar)[XB_TMO])) break; if (_sp > XB_SPIN_CAP) { atomicAdd(&(bar)[XB_TMO], 1u); break; } } } } while (0)

struct XcdBarrier {
    unsigned* bar; unsigned x;
    volatile LAS unsigned* st;
};

__device__ __forceinline__ XcdBarrier xcd_barrier_post(unsigned* bar, volatile LAS unsigned* st) {
    XcdBarrier b; b.bar = bar; b.x = xb_xcc_id(); b.st = st;
    if (threadIdx.x == 0) (void)xb_add(&bar[XB_XCNT(b.x)], 1u);
    return b;
}
__device__ __forceinline__ void xcd_barrier_complete(unsigned* bar, unsigned x, unsigned& nloc, unsigned& nx) {
    const unsigned G = gridDim.x * gridDim.y * gridDim.z;
    unsigned sum, cnt, mine, sp = 0u;
    for (;;) {
        sum = 0u; cnt = 0u; mine = 0u;
#pragma unroll
        for (unsigned j = 0; j < 16; ++j) { const unsigned c = xb_ld(&bar[XB_XCNT(j)]); sum += c; cnt += (c > 0u) ? 1u : 0u; mine = (j == x) ? c : mine; }
        if (sum == G) break;
        __builtin_amdgcn_s_sleep(1);
        if ((++sp & 255u) == 0u) { if (xb_ld(&bar[XB_TMO])) break; if (sp > XB_SPIN_CAP) { atomicAdd(&bar[XB_TMO], 1u); break; } }
    }
    nloc = mine > 0u ? mine : 1u; nx = cnt > 0u ? cnt : 1u;
}

__device__ __forceinline__ void xcd_barrier(const XcdBarrier& b) {
    asm volatile("s_waitcnt vmcnt(0)" ::: "memory");
    __syncthreads();
    if (threadIdx.x == 0) {
        unsigned* bar = b.bar;
        __builtin_amdgcn_s_waitcnt(0);
        unsigned nloc = b.st[0], nx = b.st[1];
        if (nloc == 0u) { xcd_barrier_complete(bar, b.x, nloc, nx); b.st[0] = nloc; b.st[1] = nx; }
        const unsigned old = xb_add(&bar[XB_XSUB(b.x)], 1u);
        const unsigned gen = old / nloc;
        if (old + 1u == (gen + 1u) * nloc) {
            __builtin_amdgcn_fence(__ATOMIC_RELEASE, "agent");
            asm volatile("s_waitcnt vmcnt(0)" ::: "memory");
            const unsigned og = xb_add(&bar[XB_TOP], 1u);
            const unsigned tg = og / nx;
            if (og + 1u == (tg + 1u) * nx) xb_add(&bar[XB_TOPGEN], 1u);
            else XB_SPIN(xb_ld(&bar[XB_TOPGEN]) == tg, bar);
            __builtin_amdgcn_fence(__ATOMIC_ACQUIRE, "agent");
            xb_add(&bar[XB_XGEN(b.x)], 1u);
            asm volatile("s_waitcnt vmcnt(0)" ::: "memory");
        } else {
            XB_SPIN(xb_ld(&bar[XB_XGEN(b.x)]) == gen, bar);
            __builtin_amdgcn_fence(__ATOMIC_ACQUIRE, "agent");
            asm volatile("s_waitcnt vmcnt(0)" ::: "memory");
        }
    }
    __syncthreads();
}

struct Ptrs {
    const float *x, *norm_w, *w_in, *sink, *rel_bias, *aon_w, *dec_f, *dec_b, *gn_w, *w_out, *fin_w;
    float* out;
    bf16 *win_t, *wo_t, *xn, *mix, *qa, *ka, *va, *ga, *qf, *qb, *kf, *kb, *vr, *gr, *ar, *st;
    float *cosT, *sinT, *decT, *biasT, *sink2, *gam, *ssq, *G, *yssq;
};
typedef unsigned u32x2 __attribute__((ext_vector_type(2)));
__device__ __forceinline__ float bflo(unsigned w) { return __builtin_bit_cast(float, w << 16); }
__device__ __forceinline__ float bfhi(unsigned w) { return __builtin_bit_cast(float, w & 0xffff0000u); }
__device__ __forceinline__ float bf2f(bf16 h) { return __builtin_bit_cast(float, (unsigned)h << 16); }
__device__ __forceinline__ float wave_sum(float v) {
#pragma unroll
    for (int o = 1; o < 64; o <<= 1) v += __shfl_xor(v, o);
    return v;
}
__device__ __forceinline__ float wave_max(float v) {
#pragma unroll
    for (int o = 1; o < 64; o <<= 1) v = fmaxf(v, __shfl_xor(v, o));
    return v;
}
__device__ __forceinline__ float silu_f(float v) { return v * __builtin_amdgcn_rcpf(1.0f + __builtin_amdgcn_exp2f(-v * LOG2E)); }
__device__ __forceinline__ void unpack8(const v4u w, float (&f)[8]) {
    f[0] = bflo(w.x); f[1] = bfhi(w.x); f[2] = bflo(w.y); f[3] = bfhi(w.y); f[4] = bflo(w.z); f[5] = bfhi(w.z); f[6] = bflo(w.w); f[7] = bfhi(w.w);
}
__device__ __forceinline__ v4u pack8(const float (&f)[8]) {
    v4u w; w.x = pg8::cvt_pk_bf16(f[0], f[1]); w.y = pg8::cvt_pk_bf16(f[2], f[3]); w.z = pg8::cvt_pk_bf16(f[4], f[5]); w.w = pg8::cvt_pk_bf16(f[6], f[7]); return w;
}

__device__ __forceinline__ void p0_transpose_item(const float* W, int K, int N, bf16* WT, LAS float* scr, int item, int lane) {
    const int nblk = N / 32, kb = item / nblk, nb = item % nblk, k0 = 64 * kb, n0 = 32 * nb;
#pragma unroll 8
    for (int i = 0; i < 32; ++i) { const int kk = 2 * i + (lane >> 5); scr[kk * 33 + (lane & 31)] = W[(size_t)(k0 + kk) * N + n0 + (lane & 31)]; }
    LDS_WAIT(); asm volatile("" ::: "memory");
    const int c = lane & 7;
#pragma unroll
    for (int j = 0; j < 4; ++j) { const int n = (lane >> 3) + 8 * j; const LAS float* s = scr + (8 * c) * 33 + n;
        v4u o; o.x = pk2(s[0 * 33], s[1 * 33]); o.y = pk2(s[2 * 33], s[3 * 33]); o.z = pk2(s[4 * 33], s[5 * 33]); o.w = pk2(s[6 * 33], s[7 * 33]);
        *(GAS v4u*)(WT + (size_t)(n0 + n) * K + k0 + 8 * c) = o; }
    LDS_WAIT(); asm volatile("" ::: "memory");
}
__device__ __forceinline__ int t5_bucket(int rel) {
    const int n = rel < 0 ? -rel : rel; int b;
    if (n < 8) b = n; else if (n < 12) b = 8; else if (n < 16) b = 9; else if (n < 23) b = 10; else if (n < 32) b = 11;
    else if (n < 46) b = 12; else if (n < 64) b = 13; else if (n < 91) b = 14; else b = 15;
    return b + (rel > 0 ? 16 : 0);
}
__device__ __forceinline__ void p0_prologue(const Ptrs& P, LAS unsigned char* lds, int gw, int NGW, int wave, int lane) {
    LAS float* scr = (LAS float*)(lds + RING_OFF + wave * 16384);
    constexpr int I_IN = (DM / 64) * (INW / 32), I_OUT = (DM / 64) * (DM / 32);
    for (int it = gw; it < I_IN + I_OUT; it += NGW) {
        if (it < I_IN) p0_transpose_item(P.w_in, DM, INW, P.win_t, scr, it, lane);
        else p0_transpose_item(P.w_out, DM, DM, P.wo_t, scr, it - I_IN, lane);
    }
    for (int m = gw; m < T; m += NGW) {
        const GAS f32x4* xr = (const GAS f32x4*)(P.x + (size_t)m * DM) + lane;
        const GAS f32x4* wr_ = (const GAS f32x4*)P.norm_w + lane;
        f32x4 v[8]; float s = 0.f;
#pragma unroll
        for (int j = 0; j < 8; ++j) { v[j] = xr[64 * j]; s += (v[j].x * v[j].x + v[j].y * v[j].y) + (v[j].z * v[j].z + v[j].w * v[j].w); }
        const float rstd = 1.0f / sqrtf(wave_sum(s) * (1.f / DM) + EPS);
        GAS u32x2* o8 = (GAS u32x2*)(P.xn + (size_t)m * DM) + lane;
#pragma unroll
        for (int j = 0; j < 8; ++j) { const f32x4 w = wr_[64 * j]; u32x2 o; o.x = pk2(v[j].x * rstd * w.x, v[j].y * rstd * w.y); o.y = pk2(v[j].z * rstd * w.z, v[j].w * rstd * w.w); o8[64 * j] = o; }
    }
    const int gt = gw * 64 + lane, NGT = NGW * 64;
    for (int idx = gt; idx < SEQ * 32; idx += NGT) {
        const int pos = idx >> 5, j = idx & 31;
        const float inv = exp2f(-((float)(2 * j) / 64.0f) * 13.287712379549449f);
        const float ang = (float)pos * inv;
        const double rev = (double)ang * 0.15915494309189535;
        const float fr = (float)(rev - floor(rev));
        P.cosT[idx] = __builtin_amdgcn_cosf(fr); P.sinT[idx] = __builtin_amdgcn_sinf(fr);
    }
    for (int idx = gt; idx < 4 * 8 * 128; idx += NGT) {
        const int kind = idx >> 10, h = (idx >> 7) & 7, i = idx & 127;
        const float lf = -log1pf(expf(-P.dec_f[h])), lb = -log1pf(expf(-P.dec_b[h]));
        float v;
        if (kind == 0) v = expf(lf * (float)i); else if (kind == 1) v = expf(-lb * (float)i);
        else if (kind == 2) v = 0.125f * expf(-lf * (float)i); else v = 0.125f * expf(lb * (float)i);
        P.decT[idx] = v;
    }
    for (int idx = gt; idx < 16 * BIAS_LD; idx += NGT) {
        const int h = idx / BIAS_LD, r = idx % BIAS_LD;
        P.biasT[idx] = (r <= 256) ? P.rel_bias[t5_bucket(r - 128) * 16 + h] * LOG2E : 0.f;
    }
    if (gt < 16) P.sink2[gt] = P.sink[gt] * LOG2E;
    if (gt < 16) { const int h = gt & 7; const float d = (gt < 8) ? P.dec_f[h] : P.dec_b[h]; P.gam[gt] = expf(-log1pf(expf(-d)) * 128.0f); }
}

struct EpiIn {
    static constexpr bool PERM = true, AFTER_DRAIN = false;
    bf16 *qa, *ka, *va, *ga, *qf, *qb, *kf, *kb, *vr, *gr; const float *cosT, *sinT, *decT;
    __device__ __forceinline__ void operator()(const pg8::f32x4 (&acc)[2][2][4][2], const pg8::Unit& u, int wr, int wc, int fr, int fq) const {
        const int pn = u.pn, row0 = u.pm * 256 + wr * 64 + fr, cl = wc * 32 + 8 * fq;
        if (pn >= 10 && pn < 14) {
            const bool isq = pn < 12; const int csec0 = (isq ? pn - 10 : pn - 12) * 256 + cl;
            bf16* oA = isq ? qf : kf; bf16* oB = isq ? qb : kb;
            const float* dA = decT + (isq ? 0 : 2) * 1024; const float* dB = dA + 1024;
#pragma unroll
            for (int ai = 0; ai < 2; ++ai)
#pragma unroll
                for (int m = 0; m < 4; ++m) { const int row = row0 + ai * 128 + m * 16, pos = row & (SEQ - 1), i = row & 127;
#pragma unroll
                    for (int bj = 0; bj < 2; ++bj) { const int csec = csec0 + bj * 128, head = csec >> 6, p0 = (csec & 63) >> 1;
                        const f32x4 c4 = *(const f32x4*)(cosT + pos * 32 + p0), s4 = *(const f32x4*)(sinT + pos * 32 + p0);
                        const float fA = dA[head * 128 + i], fB = dB[head * 128 + i];
                        const pg8::f32x4 v0 = acc[ai][bj][m][0], v1 = acc[ai][bj][m][1];
                        float y[8];
                        y[0] = v0[0] * c4[0] - v0[1] * s4[0]; y[1] = v0[0] * s4[0] + v0[1] * c4[0];
                        y[2] = v0[2] * c4[1] - v0[3] * s4[1]; y[3] = v0[2] * s4[1] + v0[3] * c4[1];
                        y[4] = v1[0] * c4[2] - v1[1] * s4[2]; y[5] = v1[0] * s4[2] + v1[1] * c4[2];
                        y[6] = v1[2] * c4[3] - v1[3] * s4[3]; y[7] = v1[2] * s4[3] + v1[3] * c4[3];
                        float ya[8], yb[8];
#pragma unroll
                        for (int k = 0; k < 8; ++k) { ya[k] = y[k] * fA; yb[k] = y[k] * fB; }
                        *(v4u*)(oA + (size_t)row * RQW + csec) = pack8(ya); *(v4u*)(oB + (size_t)row * RQW + csec) = pack8(yb); } }
        } else {
            bf16* base; int ldc, col0, mode;
            if (pn < 4) { base = qa; ldc = AW; col0 = pn * 256; mode = 1; }
            else if (pn == 4) { base = ka; ldc = AKW; col0 = 0; mode = 0; }
            else if (pn == 5) { base = va; ldc = AKW; col0 = 0; mode = 0; }
            else if (pn < 10) { base = ga; ldc = AW; col0 = (pn - 6) * 256; mode = 2; }
            else if (pn < 18) { base = vr; ldc = RW; col0 = (pn - 14) * 256; mode = 0; }
            else { base = gr; ldc = RW; col0 = (pn - 18) * 256; mode = 2; }
            const float sc = (mode == 1) ? 0.125f * LOG2E : 1.0f;
#pragma unroll
            for (int ai = 0; ai < 2; ++ai)
#pragma unroll
                for (int m = 0; m < 4; ++m) { bf16* rowp = base + (size_t)(row0 + ai * 128 + m * 16) * ldc + col0 + cl;
#pragma unroll
                    for (int bj = 0; bj < 2; ++bj) { const pg8::f32x4 v0 = acc[ai][bj][m][0], v1 = acc[ai][bj][m][1];
                        float y[8] = {v0[0], v0[1], v0[2], v0[3], v1[0], v1[1], v1[2], v1[3]};
                        if (mode == 2) {
#pragma unroll
                            for (int k = 0; k < 8; ++k) y[k] = silu_f(y[k]);
                        } else {
#pragma unroll
                            for (int k = 0; k < 8; ++k) y[k] *= sc;
                        }
                        *(v4u*)(rowp + bj * 128) = pack8(y); } }
        }
    }
};
struct EpiOut {
    static constexpr bool PERM = false, AFTER_DRAIN = false;
    const float* x; float* out; float* yssq;
    __device__ __forceinline__ void operator()(const pg8::f32x4 (&acc)[2][2][4][2], const pg8::Unit& u, int wr, int wc, int fr, int fq) const {
        const int row0 = u.pm * 256 + wr * 64 + fr, col0 = u.pn * 256 + wc * 32 + 4 * fq;
#pragma unroll
        for (int ai = 0; ai < 2; ++ai)
#pragma unroll
            for (int m = 0; m < 4; ++m) { const int row = row0 + ai * 128 + m * 16; const size_t off = (size_t)row * DM + col0; float ss = 0.f;
#pragma unroll
                for (int bj = 0; bj < 2; ++bj)
#pragma unroll
                    for (int n = 0; n < 2; ++n) { const f32x4 xv = *(const f32x4*)(x + off + bj * 128 + n * 16); const pg8::f32x4 a = acc[ai][bj][m][n];
                        f32x4 y; y.x = xv.x + a[0]; y.y = xv.y + a[1]; y.z = xv.z + a[2]; y.w = xv.w + a[3];
                        *(f32x4*)(out + off + bj * 128 + n * 16) = y; ss += (y.x * y.x + y.y * y.y) + (y.z * y.z + y.w * y.w); }
                ss += __shfl_xor(ss, 16); ss += __shfl_xor(ss, 32);
                if (fq == 0) yssq[(size_t)row * 32 + u.pn * 4 + wc] = ss; }
    }
};

__device__ __forceinline__ void attn_scalar(const Ptrs& P, int gw, int NGW, int lane) {
    for (int item = gw; item < T * AH; item += NGW) {
        const int t = item >> 4, h = item & 15, hk = h >> 2, s = t & (SEQ - 1), tb = t - s;
        float q[64];
        { const bf16* qp = P.qa + (size_t)t * AW + h * 64;
#pragma unroll
          for (int c = 0; c < 8; ++c) { const v4u w = *(const v4u*)(qp + 8 * c); float f[8]; unpack8(w, f);
#pragma unroll
              for (int k = 0; k < 8; ++k) q[8 * c + k] = f[k]; } }
        float sc[5]; float mx = P.sink2[h];
#pragma unroll
        for (int kk = 0; kk < 5; ++kk) {
            const int j = s - 128 + lane + 64 * kk; const bool valid = (j >= 0) && (j < SEQ) && (j <= s + 128);
            float d = -1e30f;
            if (valid) { const bf16* kp = P.ka + (size_t)(tb + j) * AKW + hk * 64; float a = 0.f;
#pragma unroll
                for (int c = 0; c < 8; ++c) { const v4u w = *(const v4u*)(kp + 8 * c); float f[8]; unpack8(w, f);
#pragma unroll
                    for (int k = 0; k < 8; ++k) a += q[8 * c + k] * f[k]; }
                d = a + P.biasT[h * BIAS_LD + (j - s + 128)]; }
            sc[kk] = d; mx = fmaxf(mx, d);
        }
        mx = wave_max(mx);
        float l = 0.f;
#pragma unroll
        for (int kk = 0; kk < 5; ++kk) { sc[kk] = __builtin_amdgcn_exp2f(sc[kk] - mx); l += sc[kk]; }
        l = wave_sum(l) + __builtin_amdgcn_exp2f(P.sink2[h] - mx);
        float o = 0.f; const bf16* vb = P.va + hk * 64 + lane;
#pragma unroll
        for (int kk = 0; kk < 5; ++kk) {
#pragma unroll 4
            for (int src = 0; src < 64; ++src) { const float pj = __shfl(sc[kk], src); int j = s - 128 + src + 64 * kk; j = j < 0 ? 0 : (j > SEQ - 1 ? SEQ - 1 : j);
                o += pj * bf2f(vb[(size_t)(tb + j) * AKW]); }
        }
        o = o / l;
        P.ar[(size_t)t * AW + h * 64 + lane] = (bf16)f2bf(o);
        const float ss = wave_sum(o * o); if (lane == 0) P.ssq[t * 16 + h] = ss;
    }
}
__device__ __forceinline__ void attn_norm(const Ptrs& P, int gw, int NGW, int lane) {
    for (int t = gw; t < T; t += NGW) {
        float ss = (lane < 16) ? P.ssq[t * 16 + lane] : 0.f; ss = wave_sum(ss);
        const float ra = 1.0f / sqrtf(ss * (1.0f / AW) + EPS);
#pragma unroll
        for (int j = 0; j < 2; ++j) { const int col = j * 512 + lane * 8;
            const v4u a = *(const v4u*)(P.ar + (size_t)t * AW + col), g = *(const v4u*)(P.ga + (size_t)t * AW + col);
            const f32x4 w0 = *(const f32x4*)(P.aon_w + col), w1 = *(const f32x4*)(P.aon_w + col + 4);
            float fa[8], fg[8], y[8]; unpack8(a, fa); unpack8(g, fg);
            const float w[8] = {w0.x, w0.y, w0.z, w0.w, w1.x, w1.y, w1.z, w1.w};
#pragma unroll
            for (int k = 0; k < 8; ++k) y[k] = (fa[k] * ra) * w[k] * fg[k];
            *(v4u*)(P.mix + (size_t)t * DM + col) = pack8(y); }
    }
}
__device__ __forceinline__ void ret_kv_scalar(const Ptrs& P, int gt, int NGT) {
    for (int idx = gt; idx < NB * RH * NC * 2 * 8192; idx += NGT) {
        const int e = idx & 8191, dv = e >> 6, dk = e & 63, dir = (idx >> 13) & 1, c = (idx >> 14) & 127, h = (idx >> 21) & 7, b = idx >> 24;
        const size_t t0 = (size_t)b * SEQ + c * CH;
        const bf16* vp = P.vr + t0 * RW + h * RDV + dv; const bf16* kp = (dir ? P.kb : P.kf) + t0 * RQW + h * RDK + dk;
        float a = 0.f;
#pragma unroll 8
        for (int j = 0; j < CH; ++j) a += bf2f(vp[(size_t)j * RW]) * bf2f(kp[(size_t)j * RQW]);
        P.G[idx] = a;
    }
}
__device__ __forceinline__ void ret_scan(const Ptrs& P, int gt, int NGT) {
    for (int q = gt; q < NB * RH * 2 * 2048; q += NGT) {
        const int e4 = q & 2047, dir = (q >> 11) & 1, h = (q >> 12) & 7, b = q >> 15;
        const float gam = P.gam[dir * 8 + h];
        f32x4 S = {0.f, 0.f, 0.f, 0.f};
        for (int c0 = 0; c0 < NC; c0 += 8) {
            f32x4 g[8];
#pragma unroll
            for (int k = 0; k < 8; ++k) { const int c = dir ? (NC - 1 - (c0 + k)) : (c0 + k); g[k] = *(const f32x4*)(P.G + ((((size_t)(b * RH + h) * NC + c) * 2 + dir) * 8192 + e4 * 4)); }
#pragma unroll
            for (int k = 0; k < 8; ++k) { const int c = dir ? (NC - 1 - (c0 + k)) : (c0 + k);
                u32x2 o; o.x = pk2(S.x, S.y); o.y = pk2(S.z, S.w);
                *(u32x2*)(P.st + ((((size_t)(b * RH + h) * NC + c) * 2 + dir) * 8192 + e4 * 4)) = o;
                S = (S + g[k]) * gam; }
        }
    }
}
__device__ __forceinline__ void ret_out_scalar(const Ptrs& P, int gw, int NGW, int lane) {
    for (int item = gw; item < T * RH; item += NGW) {
        const int t = item >> 3, h = item & 7, i = t & 127, c = (t & (SEQ - 1)) >> 7, b = t >> 14, t0 = t - i;
        const bf16* p1 = P.qf + (size_t)t * RQW + h * 64; const bf16* p2 = P.qb + (size_t)t * RQW + h * 64;
        float a[2];
#pragma unroll
        for (int jj = 0; jj < 2; ++jj) { const int j = lane + 64 * jj; const bool fw = (j <= i);
            const bf16* kp = (fw ? P.kf : P.kb) + (size_t)(t0 + j) * RQW + h * 64; float s = 0.f;
#pragma unroll 1
            for (int cc = 0; cc < 8; ++cc) { float f[8], q1[8], q2[8]; unpack8(*(const v4u*)(kp + 8 * cc), f); unpack8(*(const v4u*)(p1 + 8 * cc), q1); unpack8(*(const v4u*)(p2 + 8 * cc), q2);
#pragma unroll
                for (int k = 0; k < 8; ++k) s += (fw ? q1[k] : q2[k]) * f[k]; }
            a[jj] = s; }
        float o0 = 0.f, o1 = 0.f; const bf16* vp = P.vr + (size_t)t0 * RW + h * RDV + lane;
#pragma unroll
        for (int jj = 0; jj < 2; ++jj) {
#pragma unroll 4
            for (int src = 0; src < 64; ++src) { const float aj = __shfl(a[jj], src); const bf16* vr_ = vp + (size_t)(src + 64 * jj) * RW; o0 += aj * bf2f(vr_[0]); o1 += aj * bf2f(vr_[64]); } }
#pragma unroll
        for (int dir = 0; dir < 2; ++dir) { const bf16* sp = P.st + ((((size_t)(b * RH + h) * NC + c) * 2 + dir) * 8192); const bf16* qp = dir ? p2 : p1;
#pragma unroll
            for (int dd = 0; dd < 2; ++dd) { const bf16* rp = sp + (lane + 64 * dd) * 64; float s = 0.f;
#pragma unroll 1
                for (int cc = 0; cc < 8; ++cc) { float f[8], q1[8]; unpack8(*(const v4u*)(rp + 8 * cc), f); unpack8(*(const v4u*)(qp + 8 * cc), q1);
#pragma unroll
                    for (int k = 0; k < 8; ++k) s += q1[k] * f[k]; }
                if (dd == 0) o0 += s; else o1 += s; } }
        const float mu = wave_sum(o0 + o1) * (1.0f / RDV); const float d0 = o0 - mu, d1 = o1 - mu;
        const float var = wave_sum(d0 * d0 + d1 * d1) * (1.0f / RDV); const float rs = 1.0f / sqrtf(var + EPS);
        const int col = h * RDV + lane;
        const float y0 = d0 * rs * P.gn_w[col] * bf2f(P.gr[(size_t)t * RW + col]), y1 = d1 * rs * P.gn_w[col + 64] * bf2f(P.gr[(size_t)t * RW + col + 64]);
        P.mix[(size_t)t * DM + AW + col] = (bf16)f2bf(y0); P.mix[(size_t)t * DM + AW + col + 64] = (bf16)f2bf(y1);
    }
}
__device__ __forceinline__ void final_norm(const Ptrs& P, int gw, int NGW, int lane) {
    for (int m = gw; m < T; m += NGW) {
        float ss = (lane < 32) ? P.yssq[(size_t)m * 32 + lane] : 0.f; ss = wave_sum(ss);
        const float rstd = 1.0f / sqrtf(ss * (1.0f / DM) + EPS);
        GAS f32x4* yr = (GAS f32x4*)(P.out + (size_t)m * DM) + lane; const GAS f32x4* wr_ = (const GAS f32x4*)P.fin_w + lane;
#pragma unroll
        for (int j = 0; j < 8; ++j) { const f32x4 y = yr[64 * j], w = wr_[64 * j]; f32x4 o; o.x = y.x * rstd * w.x; o.y = y.y * rstd * w.y; o.z = y.z * rstd * w.z; o.w = y.w * rstd * w.w; yr[64 * j] = o; }
    }
}

#ifndef MK_N_LAUNCHES
#define MK_N_LAUNCHES 7
#endif
constexpr int N_PHASES = 7;
struct Args { const float* in[11]; float* out; unsigned char* ws; int ph_lo, ph_hi; };
__device__ __forceinline__ void make_ptrs(Ptrs& P, const Args& args) {
    unsigned char* ws = args.ws;
    P.x = args.in[0]; P.norm_w = args.in[1]; P.w_in = args.in[2]; P.sink = args.in[3]; P.rel_bias = args.in[4]; P.aon_w = args.in[5];
    P.dec_f = args.in[6]; P.dec_b = args.in[7]; P.gn_w = args.in[8]; P.w_out = args.in[9]; P.fin_w = args.in[10]; P.out = args.out;
    P.win_t = (bf16*)(ws + WS_WIN); P.wo_t = (bf16*)(ws + WS_WO); P.xn = (bf16*)(ws + WS_XN); P.mix = (bf16*)(ws + WS_MIX);
    P.qa = (bf16*)(ws + WS_QA); P.ka = (bf16*)(ws + WS_KA); P.va = (bf16*)(ws + WS_VA); P.ga = (bf16*)(ws + WS_GA);
    P.qf = (bf16*)(ws + WS_QF); P.qb = (bf16*)(ws + WS_QB); P.kf = (bf16*)(ws + WS_KF); P.kb = (bf16*)(ws + WS_KB);
    P.vr = (bf16*)(ws + WS_VR); P.gr = (bf16*)(ws + WS_GR); P.ar = (bf16*)(ws + WS_AR); P.st = (bf16*)(ws + WS_ST);
    P.cosT = (float*)(ws + WS_COS); P.sinT = (float*)(ws + WS_SIN); P.decT = (float*)(ws + WS_DEC); P.biasT = (float*)(ws + WS_BIAS);
    P.sink2 = (float*)(ws + WS_SINK); P.gam = (float*)(ws + WS_GAM); P.ssq = (float*)(ws + WS_SSQ); P.G = (float*)(ws + WS_G); P.yssq = (float*)(ws + WS_YSSQ);

}
__global__ void __launch_bounds__(NWAVES * 64, 2) hymba_fwd(Args args) {
    extern __shared__ __attribute__((aligned(16))) unsigned char lds_raw[];
    LAS unsigned char* lds = (LAS unsigned char*)lds_raw;
    volatile LAS unsigned* MISC = (volatile LAS unsigned*)(lds + MISC_OFF);
    const int tid = threadIdx.x, lane = tid & 63, wave = __builtin_amdgcn_readfirstlane(tid >> 6);
    const int G = gridDim.x, bx = blockIdx.x, vcu = (G % 8 == 0) ? (bx % 8) * (G / 8) + bx / 8 : bx;
    const int gw = vcu * NWAVES + wave, NGW = G * NWAVES, gt = gw * 64 + lane, NGT = NGW * 64;
    unsigned char* ws = args.ws;
    gu32* ctl = (gu32*)(ws + WS_CTL);
    for (int u = tid; u < (LDS_BYTES - LDSCTL_OFF) / 4; u += NWAVES * 64) ((LAS unsigned*)(lds + LDSCTL_OFF))[u] = 0u;
    __syncthreads();
    XcdBarrier bar; bar.bar = (unsigned*)(ctl + CW_BAR); bar.x = 0; bar.st = nullptr;
    if (MK_N_LAUNCHES == 1) bar = xcd_barrier_post((unsigned*)(ctl + CW_BAR), MISC + 8);
    const int lo = args.ph_lo, hi = args.ph_hi;
#ifndef TEST_PHASES
#define TEST_PHASES 127
#endif
#define IN(k) (((TEST_PHASES >> (k)) & 1) && lo <= (k) && (k) < hi)
#define SEAM(k) do { if (IN(k) && IN((k) + 1)) xcd_barrier(bar); } while (0)

    if (IN(0)) { Ptrs P; make_ptrs(P, args); p0_prologue(P, lds, gw, NGW, wave, lane); SEAM(0); }
    if (IN(1)) { Ptrs P; make_ptrs(P, args);
        pg8::Gemm g{P.xn, P.win_t, T, INW, DM}; pg8::StaticOrder S; S.init(T, INW, G, bx);
        EpiIn E{P.qa, P.ka, P.va, P.ga, P.qf, P.qb, P.kf, P.kb, P.vr, P.gr, P.cosT, P.sinT, P.decT};
        pg8::gemm_phase<EpiIn, pg8::StaticOrder, true, true>(lds + RING_OFF, g, S, E);
        SEAM(1);
    }
    if (IN(2)) { Ptrs P; make_ptrs(P, args); attn_scalar(P, gw, NGW, lane); ret_kv_scalar(P, gt, NGT); SEAM(2); }
    if (IN(3)) { Ptrs P; make_ptrs(P, args); ret_scan(P, gt, NGT); attn_norm(P, gw, NGW, lane); SEAM(3); }
    if (IN(4)) { Ptrs P; make_ptrs(P, args); ret_out_scalar(P, gw, NGW, lane); SEAM(4); }
    if (IN(5)) { Ptrs P; make_ptrs(P, args);
        pg8::Gemm g{P.mix, P.wo_t, T, DM, DM}; pg8::StaticOrder S; S.init(T, DM, G, bx);
        EpiOut E{P.x, P.out, P.yssq};
        pg8::gemm_phase<EpiOut, pg8::StaticOrder, true, true>(lds + RING_OFF, g, S, E);
        SEAM(5);
    }
    if (IN(6)) { Ptrs P; make_ptrs(P, args); final_norm(P, gw, NGW, lane); }
#undef IN
#undef SEAM
}

extern "C" void kernel_launch(void* const* d_in, const int* in_sizes, int n_in, void* d_out, int out_size, void* d_ws, size_t ws_size, hipStream_t stream) {
    static int grid = 0;
    if (grid == 0) {
        if (n_in != 11 || in_sizes[0] != T * DM || out_size != T * DM || ws_size < WS_END) {
            fprintf(stderr, "kernel_launch: unexpected shapes: n_in %d in0 %d out %d ws %zu (need %zu)\n", n_in, n_in > 0 ? in_sizes[0] : -1, out_size, ws_size, (size_t)WS_END); grid = -1; return; }
        int dev = 0, cus = 0;
        if (hipGetDevice(&dev) != hipSuccess || hipDeviceGetAttribute(&cus, hipDeviceAttributeMultiprocessorCount, dev) != hipSuccess) { grid = -1; return; }
        if (hipFuncSetAttribute((const void*)hymba_fwd, hipFuncAttributeMaxDynamicSharedMemorySize, LDS_BYTES) != hipSuccess) { fprintf(stderr, "kernel_launch: hipFuncSetAttribute failed\n"); grid = -1; return; }
        int per_cu = 0;
        if (hipOccupancyMaxActiveBlocksPerMultiprocessor(&per_cu, (const void*)hymba_fwd, NWAVES * 64, LDS_BYTES) != hipSuccess || per_cu < 1)
            fprintf(stderr, "kernel_launch: occupancy query reports %d blocks per CU\n", per_cu);
        (void)hipGetLastError();
        grid = cus;
    }
    if (grid < 0) return;
    (void)hipMemsetAsync((char*)d_ws + WS_CTL, 0, CTL_ZERO_BYTES, stream);
    Args a{};
    for (int i = 0; i < 11; ++i) a.in[i] = (const float*)d_in[i];
    a.out = (float*)d_out; a.ws = (unsigned char*)d_ws;
    if (MK_N_LAUNCHES == 1) { a.ph_lo = 0; a.ph_hi = N_PHASES; hipLaunchKernelGGL(hymba_fwd, dim3(grid), dim3(NWAVES * 64), LDS_BYTES, stream, a); }
    else for (int li = 0; li < N_PHASES; ++li) { a.ph_lo = li; a.ph_hi = li + 1; hipLaunchKernelGGL(hymba_fwd, dim3(grid), dim3(NWAVES * 64), LDS_BYTES, stream, a); }
}
```

```cpp
#include <hip/hip_runtime.h>
#include <cstdio>
#include <cstdint>
namespace pg8 {
#define PG8_LAS __attribute__((address_space(3)))
typedef unsigned short bf16_t;
typedef short bf16x8 __attribute__((ext_vector_type(8)));
typedef float f32x4 __attribute__((ext_vector_type(4)));
typedef unsigned u32x4 __attribute__((ext_vector_type(4)));
constexpr int BM = 256, BK = 64, HALF = 128, HTB = HALF * BK * 2  , STAGE_BYTES = 8 * HTB, NXCD = 8, WGM = 8;

__host__ __device__ __forceinline__ int lds_byte(int r, int c) { const int st = (r >> 4) * 2 + (c >> 5), rr = r & 15, cc = c & 31, ob = rr * 64 + cc * 2; return st * 1024 + (ob ^ (((ob >> 9) & 1) << 5)); }
__host__ __device__ __forceinline__ void stage_rc(int b, int& R, int& C) { const int st = b / 1024, sb = b % 1024, swz = sb ^ (((sb >> 9) & 1) << 5); R = (st >> 1) * 16 + swz / 64; C = (st & 1) * 32 + (swz % 64) / 2; }
__host__ __device__ __forceinline__ int perm32(int rho) { const int n = rho >> 4, i = rho & 15; return 8 * (i >> 2) + 4 * n + (i & 3); }

struct Unit { int pm, pn; };
struct Gemm { const bf16_t* A; const bf16_t* Bt; int M, N, K; };

struct StaticOrder {
    int nM, nN, nwg, G, c;
    __host__ __device__ void init(int M, int N, int G_, int c_) { nM = M / BM; nN = N / BM; nwg = nM * nN; G = G_; c = c_; }
    __host__ __device__ bool next(int i, Unit& u) const {
        const long L = (long)i * G + c; if (L >= nwg) return false;
        int wgid = (int)L; { const int q = nwg / NXCD, r = nwg % NXCD, xcd = wgid % NXCD, off = wgid / NXCD; wgid = (xcd < r ? xcd * (q + 1) : r * (q + 1) + (xcd - r) * q) + off; }
        const int nig = WGM * nN, gid = wgid / nig, fm = gid * WGM, gsz = (nM - fm) < WGM ? (nM - fm) : WGM;
        u.pm = fm + ((wgid % nig) % gsz); u.pn = (wgid % nig) / gsz; return true;
    }
    __device__ __forceinline__ void a_ready(const Unit&) const {}
    __device__ __forceinline__ void done(const Unit&) const {}
};

__device__ __forceinline__ unsigned cvt_pk_bf16(float lo, float hi) { unsigned r; asm volatile("v_cvt_pk_bf16_f32 %0, %1, %2" : "=v"(r) : "v"(lo), "v"(hi)); return r; }
typedef float f32x2 __attribute__((ext_vector_type(2)));
template <class Epi, class Sched, bool ALIGN_EPI = false, bool SP2 = false>
__device__ __forceinline__ void gemm_phase(PG8_LAS unsigned char* lds, const Gemm g, const Sched& S, const Epi& E) {
    const int tid = threadIdx.x, wid = __builtin_amdgcn_readfirstlane(tid >> 6), lane = tid & 63, wr = wid >> 2, wc = wid & 3, fr = lane & 15, fq = lane >> 4;
    const int K = g.K, nt = K / BK;
    unsigned voffA[2], voffB[2];
#pragma unroll
    for (int i = 0; i < 2; ++i) { int R, C; stage_rc(tid * 16 + i * 8192, R, C); const int Rb = Epi::PERM ? ((R & ~31) + perm32(R & 31)) : R;
        voffA[i] = (unsigned)(R * K + C) * 2u; voffB[i] = (unsigned)(Rb * K + C) * 2u; }
    const size_t kstep = (size_t)(BK * 2);
    const size_t hstep = (size_t)HALF * K * 2;
    const size_t tstep = 2 * hstep;
    const unsigned ldsw = (unsigned)wid * 1024u;
    const int aoff = lds_byte(wr * 64 + fr, fq * 8), boff = lds_byte(wc * 32 + fr, fq * 8);
#define PG8_SA(b, h) (((b) * 2 + (h)) * HTB)
#define PG8_SB(b, h) ((4 + (b) * 2 + (h)) * HTB)
#define PG8_STAGE(bufoff, gbase, voff) do { _Pragma("unroll") for (int _i = 0; _i < 2; ++_i) \
        __builtin_amdgcn_global_load_lds((const unsigned*)((const char*)(gbase) + (voff)[_i]), (PG8_LAS unsigned*)(lds + (bufoff) + ldsw + _i * 8192), 16, 0, 0); } while (0)
#define PG8_LDA(dst, b, h) do { _Pragma("unroll") for (int m = 0; m < 4; ++m) _Pragma("unroll") for (int k = 0; k < 2; ++k) dst[m][k] = *(const PG8_LAS bf16x8*)(lds + PG8_SA(b, h) + aoff + m * 2048 + k * 1024); } while (0)
#define PG8_LDB(dst, b, h) do { _Pragma("unroll") for (int n = 0; n < 2; ++n) _Pragma("unroll") for (int k = 0; k < 2; ++k) dst[n][k] = *(const PG8_LAS bf16x8*)(lds + PG8_SB(b, h) + boff + n * 2048 + k * 1024); } while (0)
#define PG8_MMA(ai, bj, At, Bt) do { __builtin_amdgcn_s_setprio(1); _Pragma("unroll") for (int m = 0; m < 4; ++m) _Pragma("unroll") for (int n = 0; n < 2; ++n) _Pragma("unroll") for (int k = 0; k < 2; ++k) \
        acc[ai][bj][m][n] = __builtin_amdgcn_mfma_f32_16x16x32_bf16(Bt[n][k], At[m][k], acc[ai][bj][m][n], 0, 0, 0); __builtin_amdgcn_s_setprio(0); } while (0)
#define PG8_WAIT_V(n) asm volatile("s_waitcnt vmcnt(" #n ")" ::: "memory")
#define PG8_WAIT_V_SEL(f) asm volatile("v_readfirstlane_b32 s100, %0\n\ts_nop 4\n\ts_cmp_lg_u32 s100, 0\n\ts_cbranch_scc0 .Lpgw%=a\n\ts_waitcnt vmcnt(24)\n\ts_branch .Lpgw%=b\n.Lpgw%=a:\n\ts_waitcnt vmcnt(8)\n.Lpgw%=b:" :: "v"(f) : "memory", "scc", "s100")
#define PG8_WAIT_L(n) asm volatile("s_waitcnt lgkmcnt(" #n ")" ::: "memory")
#define PG8_BAR __builtin_amdgcn_s_barrier()
#define PG8_SCHED __builtin_amdgcn_sched_barrier(0)
    Unit cur, nxt; int ui = 0;
    if (!S.next(0, cur)) return;
    f32x4 acc[2][2][4][2];
#pragma unroll
    for (int a = 0; a < 2; ++a)
#pragma unroll
        for (int b = 0; b < 2; ++b)
#pragma unroll
            for (int m = 0; m < 4; ++m)
#pragma unroll
                for (int n = 0; n < 2; ++n) acc[a][b][m][n] = (f32x4){0.f, 0.f, 0.f, 0.f};
    bf16x8 At[4][2], B0[2][2], B1[2][2];
    const char* cA = (const char*)g.A + (size_t)cur.pm * tstep; const char* cB = (const char*)g.Bt + (size_t)cur.pn * tstep;
    S.a_ready(cur);
    if constexpr (SP2) {
        PG8_STAGE(PG8_SB(0, 0), cB, voffB); PG8_STAGE(PG8_SB(0, 1), cB + hstep, voffB); PG8_STAGE(PG8_SA(0, 0), cA, voffA); PG8_STAGE(PG8_SA(0, 1), cA + hstep, voffA);
        if (wr == 1) PG8_BAR;
        PG8_WAIT_V(2); PG8_BAR;
        PG8_STAGE(PG8_SB(1, 0), cB + kstep, voffB); PG8_STAGE(PG8_SA(1, 0), cA + kstep, voffA); PG8_STAGE(PG8_SB(1, 1), cB + hstep + kstep, voffB);
        PG8_WAIT_V(6); PG8_BAR;
    } else {
        PG8_STAGE(PG8_SB(0, 0), cB, voffB); PG8_STAGE(PG8_SA(0, 0), cA, voffA); PG8_STAGE(PG8_SB(0, 1), cB + hstep, voffB); PG8_STAGE(PG8_SA(0, 1), cA + hstep, voffA);
        if (wr == 1) PG8_BAR;
        PG8_WAIT_V(4); PG8_BAR;
        PG8_STAGE(PG8_SB(1, 0), cB + kstep, voffB); PG8_STAGE(PG8_SA(1, 0), cA + kstep, voffA); PG8_STAGE(PG8_SB(1, 1), cB + hstep + kstep, voffB);
        PG8_WAIT_V(6); PG8_BAR;
    }
    for (;;) {
        const bool has_next = S.next(ui + 1, nxt);
        const char* nA = has_next ? (const char*)g.A + (size_t)nxt.pm * tstep : cA; const char* nB = has_next ? (const char*)g.Bt + (size_t)nxt.pn * tstep : cB;
        for (int t = 0; t < nt; t += 2) {
            const bool last = (t == nt - 2);
            const int rlx = (Epi::EPI_STORES >= 16 && t == 0 && ui > 0) ? 1 : 0;
            if constexpr (Epi::SCALE_AT >= 0) { if (t == Epi::SCALE_AT) E.scale(acc, cur, wr, wc, fr, fq); }
            const char* a1 = cA + (size_t)(t + 1) * kstep;
            const char* a2 = last ? nA : cA + (size_t)(t + 2) * kstep; const char* b2 = last ? nB : cB + (size_t)(t + 2) * kstep;
            const char* a3 = a2 + kstep; const char* b3 = b2 + kstep;
            if (last && has_next) S.a_ready(nxt);
            if constexpr (SP2) {
            PG8_LDB(B0, 0, 0); PG8_LDB(B1, 0, 1); PG8_SCHED; PG8_LDA(At, 0, 0); PG8_STAGE(PG8_SA(1, 1), a1 + hstep, voffA);
            PG8_WAIT_V_SEL(rlx); PG8_WAIT_L(0); PG8_BAR; PG8_MMA(0, 0, At, B0); PG8_MMA(0, 1, At, B1); PG8_BAR; PG8_SCHED;
            PG8_LDA(At, 0, 1); PG8_STAGE(PG8_SB(0, 0), b2, voffB); PG8_STAGE(PG8_SB(0, 1), b2 + hstep, voffB); PG8_STAGE(PG8_SA(0, 0), a2, voffA);
            PG8_WAIT_V_SEL(rlx); PG8_WAIT_L(0); PG8_BAR; PG8_MMA(1, 0, At, B0); PG8_MMA(1, 1, At, B1); PG8_BAR; PG8_SCHED;
            PG8_LDB(B0, 1, 0); PG8_LDB(B1, 1, 1); PG8_SCHED; PG8_LDA(At, 1, 0); PG8_STAGE(PG8_SA(0, 1), a2 + hstep, voffA);
            PG8_WAIT_V(8); PG8_WAIT_L(0); PG8_BAR; PG8_MMA(0, 0, At, B0); PG8_MMA(0, 1, At, B1); PG8_BAR; PG8_SCHED;
            PG8_LDA(At, 1, 1); PG8_STAGE(PG8_SB(1, 0), b3, voffB); PG8_STAGE(PG8_SB(1, 1), b3 + hstep, voffB); PG8_STAGE(PG8_SA(1, 0), a3, voffA);
            PG8_WAIT_V(8); PG8_WAIT_L(0); PG8_BAR; PG8_MMA(1, 0, At, B0); PG8_MMA(1, 1, At, B1); PG8_BAR; PG8_SCHED;
            } else {
            PG8_LDB(B0, 0, 0); PG8_SCHED; PG8_LDA(At, 0, 0); PG8_STAGE(PG8_SA(1, 1), a1 + hstep, voffA);
            PG8_WAIT_L(8); PG8_BAR; PG8_WAIT_L(0); PG8_MMA(0, 0, At, B0); PG8_BAR; PG8_SCHED;
            PG8_LDB(B1, 0, 1); PG8_STAGE(PG8_SB(0, 0), b2, voffB);
            PG8_BAR; PG8_WAIT_L(0); PG8_MMA(0, 1, At, B1); PG8_BAR;
            PG8_LDA(At, 0, 1); PG8_STAGE(PG8_SA(0, 0), a2, voffA);
            PG8_BAR; PG8_WAIT_L(0); PG8_MMA(1, 0, At, B0); PG8_BAR; PG8_SCHED;
            PG8_STAGE(PG8_SB(0, 1), b2 + hstep, voffB);
            PG8_WAIT_V(6); PG8_BAR; PG8_MMA(1, 1, At, B1); PG8_BAR;
            PG8_LDB(B0, 1, 0); PG8_SCHED; PG8_LDA(At, 1, 0); PG8_STAGE(PG8_SA(0, 1), a2 + hstep, voffA);
            PG8_WAIT_L(8); PG8_BAR; PG8_WAIT_L(0); PG8_MMA(0, 0, At, B0); PG8_BAR; PG8_SCHED;
            PG8_LDB(B1, 1, 1); PG8_STAGE(PG8_SB(1, 0), b3, voffB);
            PG8_BAR; PG8_WAIT_L(0); PG8_MMA(0, 1, At, B1); PG8_BAR;
            PG8_LDA(At, 1, 1); PG8_STAGE(PG8_SA(1, 0), a3, voffA);
            PG8_BAR; PG8_WAIT_L(0); PG8_MMA(1, 0, At, B0); PG8_BAR; PG8_SCHED;
            PG8_STAGE(PG8_SB(1, 1), b3 + hstep, voffB);
            PG8_WAIT_V(6); PG8_BAR; PG8_MMA(1, 1, At, B1); PG8_BAR;
            }
        }
        if constexpr (ALIGN_EPI) { if (wr == 0) PG8_BAR; }
        if constexpr (!Epi::AFTER_DRAIN) { E(acc, cur, wr, wc, fr, fq); S.done(cur); }
        if (!has_next) break;
#pragma unroll
        for (int a = 0; a < 2; ++a)
#pragma unroll
            for (int b = 0; b < 2; ++b)
#pragma unroll
                for (int m = 0; m < 4; ++m)
#pragma unroll
                    for (int n = 0; n < 2; ++n) acc[a][b][m][n] = (f32x4){0.f, 0.f, 0.f, 0.f};
        cur = nxt; cA = nA; cB = nB; ++ui;
        if constexpr (ALIGN_EPI) { if (wr == 1) PG8_BAR; }
    }
    PG8_WAIT_V(0);
    if constexpr (!ALIGN_EPI) { if (wr == 0) PG8_BAR; }
    PG8_BAR;
    if constexpr (Epi::AFTER_DRAIN) { E.fused(acc, cur, wr, wc, fr, fq, lds, wid, lane); S.done(cur); }
#undef PG8_SA
#undef PG8_SB
#undef PG8_STAGE
#undef PG8_LDA
#undef PG8_LDB
#undef PG8_MMA
#undef PG8_WAIT_V
#undef PG8_WAIT_L
#undef PG8_BAR
#undef PG8_SCHED
}
}
#define GAS __attribute__((address_space(1)))
#define LAS __attribute__((address_space(3)))
typedef unsigned short bf16;
typedef unsigned v4u __attribute__((ext_vector_type(4)));
typedef float f32x4 __attribute__((ext_vector_type(4)));
typedef short bf16x8 __attribute__((ext_vector_type(8)));
typedef GAS unsigned gu32;
typedef GAS unsigned long long gu64;
#define RLX_AGENT __ATOMIC_RELAXED, __HIP_MEMORY_SCOPE_AGENT
#define LDS_WAIT() asm volatile("s_waitcnt lgkmcnt(0)" ::: "memory")
#define VM_WAIT() asm volatile("s_waitcnt vmcnt(0)" ::: "memory")
__device__ __forceinline__ unsigned long long rt() { return __builtin_amdgcn_s_memrealtime(); }
__device__ __forceinline__ unsigned f2bf(float f) { unsigned u = __builtin_bit_cast(unsigned, f); return (u + 0x7fffu + ((u >> 16) & 1u)) >> 16; }
__device__ __forceinline__ unsigned pk2(float lo, float hi) { return f2bf(lo) | (f2bf(hi) << 16); }

constexpr int NB = 2, SEQ = 16384, T = NB * SEQ, DM = 2048, INW = 5632;
constexpr int AH = 16, AHD = 64, AW = 1024, AKW = 256;
constexpr int RH = 8, RDK = 64, RDV = 128, RQW = 512, RW = 1024, CH = 128, NC = SEQ / CH;
constexpr float EPS = 1e-6f, LOG2E = 1.4426950408889634f;
constexpr int BIAS_LD = 260;
constexpr int NWAVES = 8;

constexpr size_t MiB = 1u << 20;
constexpr size_t WS_CTL = 0, CTL_ZERO_BYTES = 32768;
constexpr size_t WS_COS = 1 * MiB, WS_SIN = 3 * MiB;
constexpr size_t WS_DEC = 5 * MiB;
constexpr size_t WS_BIAS = 5 * MiB + 65536;
constexpr size_t WS_SINK = 5 * MiB + 131072;
constexpr size_t WS_GAM = 5 * MiB + 131072 + 256;
constexpr size_t WS_WIN = 8 * MiB;
constexpr size_t WS_WO = 30 * MiB;
constexpr size_t WS_XN = 40 * MiB;
constexpr size_t WS_MIX = WS_XN;
constexpr size_t WS_QA = 168 * MiB, WS_KA = 232 * MiB, WS_VA = 248 * MiB, WS_GA = 264 * MiB;
constexpr size_t WS_QF = 328 * MiB, WS_QB = 360 * MiB, WS_KF = 392 * MiB, WS_KB = 424 * MiB, WS_VR = 456 * MiB, WS_GR = 520 * MiB;
constexpr size_t WS_SSQ = 648 * MiB;
constexpr size_t WS_G = 652 * MiB;
constexpr size_t WS_ST = 780 * MiB;
constexpr size_t WS_DLT = 848 * MiB;
constexpr size_t WS_END = 976 * MiB;
constexpr int CW_TMO = 0, CW_CODE = 1, CW_BAR = 4096;

constexpr int RING_OFF = 0, RING_BYTES = 131072;
constexpr int LDSCTL_OFF = 139264, MISC_OFF = LDSCTL_OFF + 320;
constexpr int LDS_BYTES = 147456;
#define XB_TMO      128
#define XB_XCNT(j)  (256  + 64 * (j))
#define XB_XSUB(j)  (1280 + 64 * (j))
#define XB_XGEN(j)  (2304 + 64 * (j))
#define XB_TOP      3328
#define XB_TOPGEN   3392
#define XCD_BAR_WORDS 3456
#define XB_SPIN_CAP (1u << 24)

__device__ __forceinline__ unsigned xb_ld(unsigned* p)              { return __hip_atomic_load(p, __ATOMIC_RELAXED, __HIP_MEMORY_SCOPE_AGENT); }
__device__ __forceinline__ unsigned xb_add(unsigned* p, unsigned v) { return __hip_atomic_fetch_add(p, v, __ATOMIC_RELAXED, __HIP_MEMORY_SCOPE_AGENT); }
__device__ __forceinline__ unsigned xb_xcc_id() { return (unsigned)__builtin_amdgcn_s_getreg((3 << 11) | 20) & 0xFu; }
#define XB_SPIN(cond, bar) do { unsigned _sp = 0; while (cond) { __builtin_amdgcn_s_sleep(1); \
    if ((++_sp & 255u) == 0u) { if (xb_ld(&(bar)[XB_TMO])) break; if (_sp > XB_SPIN_CAP) { atomicAdd(&(bar)[XB_TMO], 1u); break; } } } } while (0)

struct XcdBarrier {
    unsigned* bar; unsigned x;
    volatile LAS unsigned* st;
};

__device__ __forceinline__ XcdBarrier xcd_barrier_post(unsigned* bar, volatile LAS unsigned* st) {
    XcdBarrier b; b.bar = bar; b.x = xb_xcc_id(); b.st = st;
    if (threadIdx.x == 0) (void)xb_add(&bar[XB_XCNT(b.x)], 1u);
    return b;
}
__device__ __forceinline__ void xcd_barrier_complete(unsigned* bar, unsigned x, unsigned& nloc, unsigned& nx) {
    const unsigned G = gridDim.x * gridDim.y * gridDim.z;
    unsigned sum, cnt, mine, sp = 0u;
    for (;;) {
        sum = 0u; cnt = 0u; mine = 0u;
#pragma unroll
        for (unsigned j = 0; j < 16; ++j) { const unsigned c = xb_ld(&bar[XB_XCNT(j)]); sum += c; cnt += (c > 0u) ? 1u : 0u; mine = (j == x) ? c : mine; }
        if (sum == G) break;
        __builtin_amdgcn_s_sleep(1);
        if ((++sp & 255u) == 0u) { if (xb_ld(&bar[XB_TMO])) break; if (sp > XB_SPIN_CAP) { atomicAdd(&bar[XB_TMO], 1u); break; } }
    }
    nloc = mine > 0u ? mine : 1u; nx = cnt > 0u ? cnt : 1u;
}

__device__ __forceinline__ void xcd_barrier(const XcdBarrier& b) {
    asm volatile("s_waitcnt vmcnt(0)" ::: "memory");
    __syncthreads();
    if (threadIdx.x == 0) {
        unsigned* bar = b.bar;
        __builtin_amdgcn_s_waitcnt(0);
        unsigned nloc = b.st[0], nx = b.st[1];
        if (nloc == 0u) { xcd_barrier_complete(bar, b.x, nloc, nx); b.st[0] = nloc; b.st[1] = nx; }
        const unsigned old = xb_add(&bar[XB_XSUB(b.x)], 1u);
        const unsigned gen = old / nloc;
        if (old + 1u == (gen + 1u) * nloc) {
            __builtin_amdgcn_fence(__ATOMIC_RELEASE, "agent");
            asm volatile("s_waitcnt vmcnt(0)" ::: "memory");
            const unsigned og = xb_add(&bar[XB_TOP], 1u);
            const unsigned tg = og / nx;
            if (og + 1u == (tg + 1u) * nx) xb_add(&bar[XB_TOPGEN], 1u);
            else XB_SPIN(xb_ld(&bar[XB_TOPGEN]) == tg, bar);
            __builtin_amdgcn_fence(__ATOMIC_ACQUIRE, "agent");
            xb_add(&bar[XB_XGEN(b.x)], 1u);
            asm volatile("s_waitcnt vmcnt(0)" ::: "memory");
        } else {
            XB_SPIN(xb_ld(&bar[XB_XGEN(b.x)]) == gen, bar);
            __builtin_amdgcn_fence(__ATOMIC_ACQUIRE, "agent");
            asm volatile("s_waitcnt vmcnt(0)" ::: "memory");
        }
    }
    __syncthreads();
}

struct Ptrs {
    const float *x, *norm_w, *w_in, *sink, *rel_bias, *aon_w, *dec_f, *dec_b, *gn_w, *w_out, *fin_w;
    float* out;
    bf16 *win_t, *wo_t, *xn, *mix, *qa, *ka, *va, *ga, *qf, *qb, *kf, *kb, *vr, *gr, *st, *dlt;
    float *cosT, *sinT, *decT, *biasT, *sink2, *gam, *ssq, *ra; bf16* G;
};
typedef unsigned u32x2 __attribute__((ext_vector_type(2)));
__device__ __forceinline__ float bflo(unsigned w) { return __builtin_bit_cast(float, w << 16); }
__device__ __forceinline__ float bfhi(unsigned w) { return __builtin_bit_cast(float, w & 0xffff0000u); }
__device__ __forceinline__ float bf2f(bf16 h) { return __builtin_bit_cast(float, (unsigned)h << 16); }
__device__ __forceinline__ float wave_sum(float v) {
#pragma unroll
    for (int o = 1; o < 64; o <<= 1) v += __shfl_xor(v, o);
    return v;
}
__device__ __forceinline__ float wave_max(float v) {
#pragma unroll
    for (int o = 1; o < 64; o <<= 1) v = fmaxf(v, __shfl_xor(v, o));
    return v;
}
__device__ __forceinline__ float silu_f(float v) { return v * __builtin_amdgcn_rcpf(1.0f + __builtin_amdgcn_exp2f(-v * LOG2E)); }
__device__ __forceinline__ void unpack8(const v4u w, float (&f)[8]) {
    f[0] = bflo(w.x); f[1] = bfhi(w.x); f[2] = bflo(w.y); f[3] = bfhi(w.y); f[4] = bflo(w.z); f[5] = bfhi(w.z); f[6] = bflo(w.w); f[7] = bfhi(w.w);
}
__device__ __forceinline__ v4u pack8(const float (&f)[8]) {
    v4u w; w.x = pg8::cvt_pk_bf16(f[0], f[1]); w.y = pg8::cvt_pk_bf16(f[2], f[3]); w.z = pg8::cvt_pk_bf16(f[4], f[5]); w.w = pg8::cvt_pk_bf16(f[6], f[7]); return w;
}

__device__ __forceinline__ v4u scale8(const v4u w, float sc) { float f[8]; unpack8(w, f);
#pragma unroll
    for (int k = 0; k < 8; ++k) f[k] *= sc;
    return pack8(f); }

__device__ __forceinline__ void p0_transpose_item(const float* W, int K, int N, bf16* WT, LAS float* scr, int item, int lane) {
    const int nblk = N / 32, kb = item / nblk, nb = item % nblk, k0 = 64 * kb, n0 = 32 * nb;
#pragma unroll 8
    for (int i = 0; i < 32; ++i) { const int kk = 2 * i + (lane >> 5); scr[kk * 33 + (lane & 31)] = __builtin_nontemporal_load(W + (size_t)(k0 + kk) * N + n0 + (lane & 31)); }
    LDS_WAIT(); asm volatile("" ::: "memory");
    const int c = lane & 7;
#pragma unroll
    for (int j = 0; j < 4; ++j) { const int n = (lane >> 3) + 8 * j; const LAS float* s = scr + (8 * c) * 33 + n;
        v4u o; o.x = pk2(s[0 * 33], s[1 * 33]); o.y = pk2(s[2 * 33], s[3 * 33]); o.z = pk2(s[4 * 33], s[5 * 33]); o.w = pk2(s[6 * 33], s[7 * 33]);
        *(GAS v4u*)(WT + (size_t)(n0 + n) * K + k0 + 8 * c) = o; }
    LDS_WAIT(); asm volatile("" ::: "memory");
}
__device__ __forceinline__ int t5_bucket(int rel) {
    const int n = rel < 0 ? -rel : rel; int b;
    if (n < 8) b = n; else if (n < 12) b = 8; else if (n < 16) b = 9; else if (n < 23) b = 10; else if (n < 32) b = 11;
    else if (n < 46) b = 12; else if (n < 64) b = 13; else if (n < 91) b = 14; else b = 15;
    return b + (rel > 0 ? 16 : 0);
}
__device__ __forceinline__ void p0_prologue(const Ptrs& P, LAS unsigned char* lds, int gw, int NGW, int wave, int lane) {
    LAS float* scr = (LAS float*)(lds + RING_OFF + wave * 16384);
    constexpr int I_IN = (DM / 64) * (INW / 32), I_OUT = (DM / 64) * (DM / 32);
    for (int it = gw; it < I_IN + I_OUT; it += NGW) {
        if (it < I_IN) p0_transpose_item(P.w_in, DM, INW, P.win_t, scr, it, lane);
        else p0_transpose_item(P.w_out, DM, DM, P.wo_t, scr, it - I_IN, lane);
    }
    {
        f32x4 wv[8];
        { const GAS f32x4* wr_ = (const GAS f32x4*)P.norm_w + lane;
#pragma unroll
          for (int j = 0; j < 8; ++j) wv[j] = wr_[64 * j]; }
        for (int m = gw; m < T; m += 2 * NGW) {
            const int m2 = m + NGW;
            const bool has2 = m2 < T;
            const GAS f32x4* xa = (const GAS f32x4*)(P.x + (size_t)m * DM) + lane; const GAS f32x4* xb = (const GAS f32x4*)(P.x + (size_t)(has2 ? m2 : m) * DM) + lane;
            f32x4 va[8], vb[8]; float sa_ = 0.f, sb_ = 0.f;
#pragma unroll
            for (int j = 0; j < 8; ++j) { va[j] = __builtin_nontemporal_load(xa + 64 * j); vb[j] = __builtin_nontemporal_load(xb + 64 * j); }
#pragma unroll
            for (int j = 0; j < 8; ++j) { sa_ += (va[j].x * va[j].x + va[j].y * va[j].y) + (va[j].z * va[j].z + va[j].w * va[j].w); sb_ += (vb[j].x * vb[j].x + vb[j].y * vb[j].y) + (vb[j].z * vb[j].z + vb[j].w * vb[j].w); }
            const float ra = 1.0f / sqrtf(wave_sum(sa_) * (1.f / DM) + EPS), rb = 1.0f / sqrtf(wave_sum(sb_) * (1.f / DM) + EPS);
            GAS u32x2* oa = (GAS u32x2*)(P.xn + (size_t)m * DM) + lane; GAS u32x2* ob = (GAS u32x2*)(P.xn + (size_t)m2 * DM) + lane;
#pragma unroll
            for (int j = 0; j < 8; ++j) { const f32x4 w = wv[j]; u32x2 o; o.x = pk2(va[j].x * ra * w.x, va[j].y * ra * w.y); o.y = pk2(va[j].z * ra * w.z, va[j].w * ra * w.w); oa[64 * j] = o;
                if (has2) { u32x2 o2; o2.x = pk2(vb[j].x * rb * w.x, vb[j].y * rb * w.y); o2.y = pk2(vb[j].z * rb * w.z, vb[j].w * rb * w.w); ob[64 * j] = o2; } }
        }
    }
    const int gt = gw * 64 + lane, NGT = NGW * 64;
    for (int idx = gt; idx < SEQ * 32; idx += NGT) {
        const int pos = idx >> 5, j = idx & 31;
        const float inv = exp2f(-((float)(2 * j) / 64.0f) * 13.287712379549449f);
        const float ang = (float)pos * inv;
        const double rev = (double)ang * 0.15915494309189535;
        const float fr = (float)(rev - floor(rev));
        P.cosT[idx] = __builtin_amdgcn_cosf(fr); P.sinT[idx] = __builtin_amdgcn_sinf(fr);
    }
    for (int idx = gt; idx < 4 * 8 * 128; idx += NGT) {
        const int kind = idx >> 10, h = (idx >> 7) & 7, i = idx & 127;
        const float lf = -log1pf(expf(-P.dec_f[h])), lb = -log1pf(expf(-P.dec_b[h]));
        float v;
        if (kind == 0) v = expf(lf * (float)i); else if (kind == 1) v = expf(-lb * (float)i);
        else if (kind == 2) v = expf(-lf * (float)i); else v = expf(lb * (float)i);
        P.decT[idx] = v;
    }
    for (int idx = gt; idx < 16 * BIAS_LD; idx += NGT) {
        const int h = idx / BIAS_LD, r = idx % BIAS_LD;
        P.biasT[idx] = (r <= 256) ? P.rel_bias[t5_bucket(r - 128) * 16 + h] * LOG2E : 0.f;
    }
    if (gt < 16) P.sink2[gt] = P.sink[gt] * LOG2E;
    if (gt < 16) { const int h = gt & 7; const float d = (gt < 8) ? P.dec_f[h] : P.dec_b[h]; P.gam[gt] = expf(-log1pf(expf(-d)) * 128.0f); }
}

#ifndef P1_ST_AUX
#define P1_ST_AUX 2
#endif
__device__ __forceinline__ void st16_aux(void* base, unsigned byte_off, const v4u v) {
    const __amdgpu_buffer_rsrc_t r = __builtin_amdgcn_make_buffer_rsrc((void*)base, (short)0, 0x7ffffff0, 0x00020000);
    __builtin_amdgcn_raw_buffer_store_b128(v, r, byte_off, 0, P1_ST_AUX);
}
struct EpiIn {
    static constexpr bool PERM = true, AFTER_DRAIN = false; static constexpr int SCALE_AT = -1, EPI_STORES = 16;
    bf16 *qa, *ka, *va, *ga, *qf, *qb, *kf, *kb, *vr, *gr; const float *cosT, *sinT, *decT;
    __device__ __forceinline__ void operator()(const pg8::f32x4 (&acc)[2][2][4][2], const pg8::Unit& u, int wr, int wc, int fr, int fq) const {
        const int pn = u.pn, row0 = u.pm * 256 + wr * 64 + fr, cl = wc * 32 + 8 * fq;
        if (pn >= 10 && pn < 14) {
            const bool isq = pn < 12; const int csec0 = (isq ? pn - 10 : pn - 12) * 256 + cl;
            bf16* oA = isq ? qf : kf; const float ksc = isq ? 1.0f : 0.125f;
#pragma unroll
            for (int ai = 0; ai < 2; ++ai) {
                f32x4 c4[4], s4[4];
                const int p0 = (csec0 & 63) >> 1;
#pragma unroll
                for (int m = 0; m < 4; ++m) { const int pos = (row0 + ai * 128 + m * 16) & (SEQ - 1); c4[m] = *(const f32x4*)(cosT + pos * 32 + p0); s4[m] = *(const f32x4*)(sinT + pos * 32 + p0); }
                __builtin_amdgcn_sched_barrier(0);
#pragma unroll
                for (int m = 0; m < 4; ++m) { const int row = row0 + ai * 128 + m * 16;
#pragma unroll
                    for (int bj = 0; bj < 2; ++bj) { const int csec = csec0 + bj * 128;
                        const pg8::f32x4 v0 = acc[ai][bj][m][0], v1 = acc[ai][bj][m][1]; const f32x4 cc = c4[m] * ksc, sn = s4[m] * ksc;
                        float y[8];
                        y[0] = v0[0] * cc[0] - v0[1] * sn[0]; y[1] = v0[0] * sn[0] + v0[1] * cc[0];
                        y[2] = v0[2] * cc[1] - v0[3] * sn[1]; y[3] = v0[2] * sn[1] + v0[3] * cc[1];
                        y[4] = v1[0] * cc[2] - v1[1] * sn[2]; y[5] = v1[0] * sn[2] + v1[1] * cc[2];
                        y[6] = v1[2] * cc[3] - v1[3] * sn[3]; y[7] = v1[2] * sn[3] + v1[3] * cc[3];
                        st16_aux(oA, (unsigned)(((size_t)row * RQW + csec) * 2), pack8(y)); } }
                __builtin_amdgcn_sched_barrier(0);
            }
        } else {
            bf16* base; int ldc, col0, mode;
            if (pn < 4) { base = qa; ldc = AW; col0 = pn * 256; mode = 1; }
            else if (pn == 4) { base = ka; ldc = AKW; col0 = 0; mode = 0; }
            else if (pn == 5) { base = va; ldc = AKW; col0 = 0; mode = 0; }
            else if (pn < 10) { base = ga; ldc = AW; col0 = (pn - 6) * 256; mode = 2; }
            else if (pn < 18) { base = vr; ldc = RW; col0 = (pn - 14) * 256; mode = 0; }
            else { base = gr; ldc = RW; col0 = (pn - 18) * 256; mode = 2; }
            const float sc = (mode == 1) ? 0.125f * LOG2E : 1.0f;
#pragma unroll
            for (int ai = 0; ai < 2; ++ai)
#pragma unroll
                for (int m = 0; m < 4; ++m) { const unsigned rowoff = (unsigned)(((size_t)(row0 + ai * 128 + m * 16) * ldc + col0 + cl) * 2);
#pragma unroll
                    for (int bj = 0; bj < 2; ++bj) { const pg8::f32x4 v0 = acc[ai][bj][m][0], v1 = acc[ai][bj][m][1];
                        float y[8] = {v0[0], v0[1], v0[2], v0[3], v1[0], v1[1], v1[2], v1[3]};
                        if (mode == 2) {
#pragma unroll
                            for (int k = 0; k < 8; ++k) y[k] = silu_f(y[k]);
                        } else {
#pragma unroll
                            for (int k = 0; k < 8; ++k) y[k] *= sc;
                        }
                        st16_aux(base, rowoff + bj * 256, pack8(y)); } }
        }
    }
};


struct EpiDelta {
    static constexpr bool PERM = true, AFTER_DRAIN = false; static constexpr int SCALE_AT = AW / 64, EPI_STORES = 16;
    bf16* dl; const float* ra;
    __device__ __forceinline__ void scale(pg8::f32x4 (&acc)[2][2][4][2], const pg8::Unit& u, int wr, int wc, int fr, int fq) const {
        const float* rp = ra + u.pm * 256 + wr * 64 + fr;
#pragma unroll
        for (int ai = 0; ai < 2; ++ai)
#pragma unroll
            for (int m = 0; m < 4; ++m) { const float r = rp[ai * 128 + m * 16];
#pragma unroll
                for (int bj = 0; bj < 2; ++bj)
#pragma unroll
                    for (int n = 0; n < 2; ++n) acc[ai][bj][m][n] *= r; }
    }
    __device__ __forceinline__ void operator()(const pg8::f32x4 (&acc)[2][2][4][2], const pg8::Unit& u, int wr, int wc, int fr, int fq) const {
        const int row0 = u.pm * 256 + wr * 64 + fr, col0 = u.pn * 256 + wc * 32 + 8 * fq;
#pragma unroll
        for (int ai = 0; ai < 2; ++ai)
#pragma unroll
            for (int m = 0; m < 4; ++m) { bf16* rowp = dl + (size_t)(row0 + ai * 128 + m * 16) * DM + col0;
#pragma unroll
                for (int bj = 0; bj < 2; ++bj) { const pg8::f32x4 v0 = acc[ai][bj][m][0], v1 = acc[ai][bj][m][1];
                    const float y[8] = {v0[0], v0[1], v0[2], v0[3], v1[0], v1[1], v1[2], v1[3]};
                    *(v4u*)(rowp + bj * 128) = pack8(y);     } }
    }
};
typedef float f32x16 __attribute__((ext_vector_type(16)));
typedef short s16x4 __attribute__((ext_vector_type(4)));
typedef short v4i16_t __attribute__((ext_vector_type(4)));
typedef LAS const char* lds_cptr;
__device__ __forceinline__ int crow(int r, int hi) { return (r & 3) + 8 * (r >> 2) + 4 * hi; }
__device__ __forceinline__ s16x4 vtr(lds_cptr p) { return __builtin_bit_cast(s16x4, __builtin_amdgcn_ds_read_tr16_b64_v4i16((LAS v4i16_t*)p)); }
__device__ __forceinline__ bf16x8 vtr8(lds_cptr p) { const s16x4 lo = vtr(p), hi_ = vtr(p + 512); return (bf16x8){lo[0], lo[1], lo[2], lo[3], hi_[0], hi_[1], hi_[2], hi_[3]}; }
__device__ __forceinline__ unsigned cvtpk(float lo, float hi) { typedef float f2_t __attribute__((ext_vector_type(2))); typedef __bf16 b2_t __attribute__((ext_vector_type(2))); f2_t v = {lo, hi}; b2_t b = __builtin_convertvector(v, b2_t); return __builtin_bit_cast(unsigned, b); }
__device__ __forceinline__ void half_swap(unsigned& a, unsigned& b) { asm volatile("s_nop 1\n\tv_permlane32_swap_b32 %0, %1" : "+v"(a), "+v"(b)); }
__device__ __forceinline__ float half_swap_max(float m) { unsigned a = __builtin_bit_cast(unsigned, m), b = a; half_swap(a, b); return fmaxf(__builtin_bit_cast(float, a), __builtin_bit_cast(float, b)); }
__device__ __forceinline__ float half_swap_sum(float m) { unsigned a = __builtin_bit_cast(unsigned, m), b = a; half_swap(a, b); return __builtin_bit_cast(float, a) + __builtin_bit_cast(float, b); }
#define LDS_BAR() asm volatile("s_waitcnt lgkmcnt(0)\n\ts_barrier" ::: "memory")
__device__ __forceinline__ float amax3(float a, float b, float c) { float r; asm("v_max3_f32 %0, %1, %2, %3" : "=v"(r) : "v"(a), "v"(b), "v"(c)); return r; }
#define MFMA32(a, b, c) __builtin_amdgcn_mfma_f32_32x32x16_bf16((a), (b), (c), 0, 0, 0)
#define PK8(p, B) __builtin_bit_cast(bf16x8, (v4u){cvtpk(p[B], p[B + 1]), cvtpk(p[B + 2], p[B + 3]), cvtpk(p[B + 4], p[B + 5]), cvtpk(p[B + 6], p[B + 7])})

constexpr int A_KT = 8192, A_KCS = 1040, A_KTS = 8 * A_KCS  , A_LK = 0, A_LV = 5 * A_KTS, A_LB = A_LV + 5 * A_KT, A_LWS = A_LB + 4 * 384 * 4, A_LOST = A_LWS + 8 * 64 * 4;
static_assert(A_LOST + 8 * 4096 <= RING_BYTES, "attention LDS map");
__device__ __forceinline__ void ret_scan(const Ptrs& P, int gt, int NGT);
__device__ __forceinline__ void attn_phase(const Ptrs& P, LAS unsigned char* lds, int vcu, int G, int gt, int NGT) {
    const int tid = threadIdx.x, lane = tid & 63, r32 = lane & 31, hi = lane >> 5, wid = __builtin_amdgcn_readfirstlane(tid >> 6), g = wid >> 1, sb = wid & 1;
    int cur_hk = -1;
    LAS float* wsf = (LAS float*)(lds + A_LWS) + wid * 64;
    constexpr int NU = NB * (SEQ / 64) * 4;
    v4u kreg[5], vreg[5]; bf16x8 qn[4];
#define ATT_LOAD(uu) do { const int hk_ = (uu) & 3, qb_ = ((uu) >> 2) & 255, b_ = (uu) >> 10, q0_ = qb_ * 64, tb_ = b_ * SEQ; \
        const int tlo_ = q0_ >= 128 ? 0 : (q0_ >= 64 ? 1 : 2); int thi_ = (SEQ + 128 - q0_) / 64; if (thi_ > 5) thi_ = 5; \
        const bf16* ksrc = P.ka + (size_t)(tb_ + q0_ - 128 + 8 * wid + (lane >> 3)) * AKW + hk_ * 64 + (lane & 7) * 8; \
        const bf16* vsrc = P.va + (size_t)(tb_ + q0_ - 128 + 8 * wid + (lane >> 3)) * AKW + hk_ * 64 + (lane & 7) * 8; \
        _Pragma("unroll") for (int t = 0; t < 5; ++t) if (t >= tlo_ && t < thi_) { kreg[t] = *(const v4u*)(ksrc + (size_t)t * 64 * AKW); vreg[t] = *(const v4u*)(vsrc + (size_t)t * 64 * AKW); } \
        } while (0)
#define ATT_LOADQ(uu) do { const int hk_ = (uu) & 3, qb_ = ((uu) >> 2) & 255, b_ = (uu) >> 10, q0_ = qb_ * 64, tb_ = b_ * SEQ; \
        const bf16* qp = P.qa + (size_t)(tb_ + q0_ + sb * 32 + r32) * AW + (hk_ * 4 + g) * 64 + hi * 8; \
        _Pragma("unroll") for (int d0 = 0; d0 < 4; ++d0) qn[d0] = __builtin_nontemporal_load((const bf16x8*)(qp + d0 * 16)); } while (0)
    if (vcu < NU) { ATT_LOAD(vcu); ATT_LOADQ(vcu); }
    ret_scan(P, gt, NGT);
    for (int u = vcu; u < NU; u += G) {
        const int hk = u & 3, qb = (u >> 2) & 255, b = u >> 10;
        const int q0 = qb * 64, tb = b * SEQ, h = hk * 4 + g;
        const int tlo = q0 >= 128 ? 0 : (q0 >= 64 ? 1 : 2);
        int thi = (SEQ + 128 - q0) / 64; if (thi > 5) thi = 5;
        LDS_BAR();
        if (hk != cur_hk) {
            for (int e = tid; e < 4 * 384; e += NWAVES * 64) { const int gg = e / 384, i = e % 384, r128 = i - 63;
                ((LAS float*)(lds + A_LB))[e] = (r128 >= 0 && r128 <= 256) ? P.biasT[(hk * 4 + gg) * BIAS_LD + r128] - P.sink2[hk * 4 + gg] : -1e30f; }
            cur_hk = hk;
        }
#pragma unroll
        for (int t = 0; t < 5; ++t) if (t >= tlo && t < thi) { const int row = 8 * wid + (lane >> 3), pc = lane & 7;
            *(LAS v4u*)(lds + A_LK + t * A_KTS + pc * A_KCS + row * 16) = kreg[t];
            *(LAS v4u*)(lds + A_LV + t * A_KT + ((pc >> 2) * 4 + (row >> 4)) * 1024 + (row & 15) * 64 + (pc & 3) * 16) = vreg[t]; }
        bf16x8 qr[4];
#pragma unroll
        for (int d0 = 0; d0 < 4; ++d0) qr[d0] = qn[d0];
        const float sink = P.sink2[h];
        LDS_BAR();
        v4u gv[4];
#pragma unroll
        for (int i = 0; i < 4; ++i) gv[i] = __builtin_nontemporal_load((const v4u*)(P.ga + (size_t)(tb + q0 + sb * 32 + i * 8 + (lane >> 3)) * AW + h * 64 + (lane & 7) * 8));
        const f32x4 aw0 = *(const f32x4*)(P.aon_w + h * 64 + (lane & 7) * 8), aw1 = *(const f32x4*)(P.aon_w + h * 64 + (lane & 7) * 8 + 4);
        if (u + G < NU) ATT_LOAD(u + G);
        float moff = 0.f, l = 0.f; f32x16 o0 = {}, o1 = {}; bool shifted = false;
        unsigned btoff = (unsigned)(size_t)((const LAS float*)(lds + A_LB) + g * 384 + 63 - (sb * 32 + r32) + 4 * hi) + 256u * (unsigned)tlo;
        asm volatile("" : "+v"(btoff));
        bool guard = false;
        f32x16 p0, p1;
#define ATT_CINIT() do { const LAS float* bb = (const LAS float*)(size_t)btoff; _Pragma("unroll") for (int r = 0; r < 16; ++r) { p0[r] = bb[(r & 3) + 8 * (r >> 2)]; p1[r] = bb[32 + (r & 3) + 8 * (r >> 2)]; } } while (0)
        ATT_CINIT();
#pragma unroll 1
        for (int t = tlo; t < thi;) {
            const lds_cptr kb_ = (lds_cptr)(lds + A_LK + t * A_KTS) + hi * A_KCS + r32 * 16;
            bf16x8 kf[8];
#pragma unroll
            for (int d0 = 0; d0 < 4; ++d0) { kf[2 * d0] = *(const LAS bf16x8*)(kb_ + d0 * 2 * A_KCS); kf[2 * d0 + 1] = *(const LAS bf16x8*)(kb_ + d0 * 2 * A_KCS + 512); }
            __builtin_amdgcn_sched_barrier(0);
#pragma unroll
            for (int d0 = 0; d0 < 4; ++d0) { p0 = MFMA32(kf[2 * d0], qr[d0], p0); p1 = MFMA32(kf[2 * d0 + 1], qr[d0], p1); }
            const lds_cptr vp = (lds_cptr)(lds + A_LV + t * A_KT) + ((lane >> 4) & 1) * 32 + (lane & 3) * 8 + (4 * hi + ((lane & 15) >> 2)) * 64;
            if (shifted) {
#pragma unroll
                for (int r = 0; r < 16; ++r) { p0[r] -= moff; p1[r] -= moff; }
            }
            if (guard) {
                float rm = amax3(p0[0], p1[0], p0[1]);
#pragma unroll
                for (int r = 1; r < 15; ++r) rm = amax3(rm, p1[r], p0[r + 1]);
                rm = amax3(rm, p1[15], rm);
                rm = half_swap_max(rm);
                if (__any(rm > 0.f)) {
                    const float dl = fmaxf(rm, 0.f), f = __builtin_amdgcn_exp2f(-dl); l *= f; moff += dl; shifted = true;
                    if (hi == 0) wsf[r32] = f;
#pragma unroll
                    for (int r = 0; r < 16; ++r) { const float fr_ = wsf[crow(r, hi)]; o0[r] *= fr_; o1[r] *= fr_; p0[r] -= dl; p1[r] -= dl; }
                }
            }
            float ps = 0.f;
#pragma unroll
            for (int r = 0; r < 16; ++r) { p0[r] = __builtin_amdgcn_exp2f(p0[r]); p1[r] = __builtin_amdgcn_exp2f(p1[r]); ps += p0[r] + p1[r]; }
            if (!guard && __any(!(ps <= 0x1p64f))) { guard = true; ATT_CINIT(); continue; }
            l += ps;
            const bf16x8 pa0 = PK8(p0, 0), pa1 = PK8(p0, 8), pa2 = PK8(p1, 0), pa3 = PK8(p1, 8);
            btoff += 256u; ++t;
            __builtin_amdgcn_sched_barrier(0);
            ATT_CINIT();
            bf16x8 vb[8];
#pragma unroll
            for (int i = 0; i < 4; ++i) { vb[2 * i] = vtr8(vp + i * 1024); vb[2 * i + 1] = vtr8(vp + 4096 + i * 1024); }
            __builtin_amdgcn_sched_barrier(0);
            o0 = MFMA32(pa0, vb[0], o0); o1 = MFMA32(pa0, vb[1], o1);
            o0 = MFMA32(pa1, vb[2], o0); o1 = MFMA32(pa1, vb[3], o1);
            o0 = MFMA32(pa2, vb[4], o0); o1 = MFMA32(pa2, vb[5], o1);
            o0 = MFMA32(pa3, vb[6], o0); o1 = MFMA32(pa3, vb[7], o1);
        }
#undef ATT_CINIT
        if (u + G < NU) ATT_LOADQ(u + G);
        l = half_swap_sum(l) + __builtin_amdgcn_exp2f(-moff);
        if (hi == 0) wsf[32 + r32] = 1.0f / l;
        LAS bf16* stg = (LAS bf16*)(lds + A_LOST) + wid * 2048;
#pragma unroll
        for (int r = 0; r < 16; ++r) { const int orow = crow(r, hi); const float il = wsf[32 + orow];
            stg[orow * 64 + r32] = (bf16)f2bf(o0[r] * il); stg[orow * 64 + 32 + r32] = (bf16)f2bf(o1[r] * il); }
        asm volatile("s_waitcnt lgkmcnt(0)" ::: "memory");
        bf16* ow = P.mix + (size_t)(tb + q0 + sb * 32) * DM + h * 64;
        const float awv[8] = {aw0.x, aw0.y, aw0.z, aw0.w, aw1.x, aw1.y, aw1.z, aw1.w};
        float ssv[4];
#pragma unroll
        for (int i = 0; i < 4; ++i) { const int row = i * 8 + (lane >> 3), ch = lane & 7; const v4u v = *(const LAS v4u*)(stg + row * 64 + ch * 8);
            float a[8], g8[8], y[8]; unpack8(v, a); unpack8(gv[i], g8); float ss = 0.f;
#pragma unroll
            for (int k = 0; k < 8; ++k) { ss += a[k] * a[k]; y[k] = a[k] * awv[k] * g8[k]; }
            ss += __shfl_xor(ss, 1); ss += __shfl_xor(ss, 2); ss += __shfl_xor(ss, 4); ssv[i] = ss;
            *(v4u*)(ow + (size_t)row * DM + ch * 8) = pack8(y); }
        if ((lane & 7) == 0) {
#pragma unroll
            for (int i = 0; i < 4; ++i) P.ssq[(size_t)(tb + q0 + sb * 32 + i * 8 + (lane >> 3)) * 16 + h] = ssv[i];
        }
    }
#undef ATT_LOAD
#undef ATT_LOADQ
}
__device__ __forceinline__ v4u ldg16(const void* sbase, unsigned voff) { return __builtin_nontemporal_load((const v4u*)((const char*)sbase + voff)); }
constexpr int R1_LV = 0, R1_LKF = 32768, R1_LKB = 49152;
__device__ __forceinline__ void ret_kv_phase(const Ptrs& P, LAS unsigned char* lds, int vcu, int G) {
    const int tid = threadIdx.x, lane = tid & 63, r32 = lane & 31, hi = lane >> 5, wid = __builtin_amdgcn_readfirstlane(tid >> 6), dir = wid & 1, dvb = wid >> 1;
    const int trbase = ((lane >> 4) & 1) * 32 + (lane & 3) * 8 + (4 * hi + ((lane & 15) >> 2)) * 64;
    constexpr int NU = NB * RH * NC;
    const unsigned vrow0 = (unsigned)tid >> 4, vpc = (unsigned)tid & 15, krow0 = (unsigned)tid >> 3, kpc = (unsigned)tid & 7;
    const unsigned vo_v = vrow0 * (RW * 2) + vpc * 16, vo_k = krow0 * (RQW * 2) + kpc * 16;
    v4u vv[4], krv[2]; float dsf[2], dsb[2];
#define R1_LOAD(uu) do { const int c_ = (uu) & 127, h_ = ((uu) >> 7) & 7, b_ = (uu) >> 10; const size_t t0_ = (size_t)b_ * SEQ + c_ * CH; \
        _Pragma("unroll") for (int i = 0; i < 4; ++i) vv[i] = ldg16(P.vr + (t0_ + 32 * i) * RW + h_ * RDV, vo_v); \
        _Pragma("unroll") for (int i = 0; i < 2; ++i) { krv[i] = ldg16(P.kf + (t0_ + 64 * i) * RQW + h_ * RDK, vo_k); dsf[i] = P.decT[2 * 1024 + h_ * 128 + krow0 + 64 * i]; dsb[i] = P.decT[3 * 1024 + h_ * 128 + krow0 + 64 * i]; } } while (0)
    if (vcu < NU) R1_LOAD(vcu);
    for (int u = vcu; u < NU; u += G) {
        const int c = u & 127, h = (u >> 7) & 7, b = u >> 10;
        LDS_BAR();
#pragma unroll
        for (int i = 0; i < 4; ++i) { const int row = vrow0 + 32 * i; *(LAS v4u*)(lds + R1_LV + ((vpc >> 2) * 8 + (row >> 4)) * 1024 + (row & 15) * 64 + (vpc & 3) * 16) = vv[i]; }
#pragma unroll
        for (int i = 0; i < 2; ++i) { const int row = krow0 + 64 * i, off = ((kpc >> 2) * 8 + (row >> 4)) * 1024 + (row & 15) * 64 + (kpc & 3) * 16;
            *(LAS v4u*)(lds + R1_LKF + off) = scale8(krv[i], dsf[i]); *(LAS v4u*)(lds + R1_LKB + off) = scale8(krv[i], dsb[i]); }
        LDS_BAR();
        if (u + G < NU) R1_LOAD(u + G);
        f32x16 a0 = {}, a1 = {};
        const lds_cptr vb = (lds_cptr)(lds + R1_LV + dvb * 8192) + trbase, kb_ = (lds_cptr)(lds + (dir ? R1_LKB : R1_LKF)) + trbase;
#pragma unroll
        for (int ks = 0; ks < 8; ++ks) { const bf16x8 av = vtr8(vb + ks * 1024), b0 = vtr8(kb_ + ks * 1024), b1 = vtr8(kb_ + 8192 + ks * 1024);
            a0 = MFMA32(av, b0, a0); a1 = MFMA32(av, b1, a1); }
        LAS bf16* stg = (LAS bf16*)(lds + 65536) + wid * 2048;
#pragma unroll
        for (int r = 0; r < 16; ++r) { const int orow = crow(r, hi); stg[orow * 64 + r32] = (bf16)f2bf(a0[r]); stg[orow * 64 + 32 + r32] = (bf16)f2bf(a1[r]); }
        asm volatile("s_waitcnt lgkmcnt(0)" ::: "memory");
        bf16* gp = P.G + ((((size_t)(b * RH + h) * NC + c) * 2 + dir) * 8192) + dvb * 32 * 64;
#pragma unroll
        for (int i = 0; i < 4; ++i) *(v4u*)(gp + (i * 64 + lane) * 8) = *(const LAS v4u*)(stg + (i * 64 + lane) * 8);
    }
#undef R1_LOAD
}
constexpr int R3_CS = 2064, R3_TB = 8 * R3_CS;
constexpr int R3_KF = 0, R3_KB = R3_TB, R3_QF = 2 * R3_TB, R3_QB = 3 * R3_TB, R3_SF = 4 * R3_TB, R3_SB = 5 * R3_TB, R3_V = 6 * R3_TB, R3_GW = R3_V + 32768, R3_XCH = R3_GW + 512, R3_END = R3_XCH + 2048;
static_assert(R3_END <= LDSCTL_OFF && 8 * 4096 <= 2 * R3_TB, "R3 LDS map");
__device__ __forceinline__ void attn_ra(const Ptrs& P, int gt, int NGT);
template <int MODE> __device__ __forceinline__ void ret_out_phase(const Ptrs& P, LAS unsigned char* lds, int vcu, int G, int gt = 0, int NGT = 0) {
    const int tid = threadIdx.x, lane = tid & 63, r32 = lane & 31, hi = lane >> 5, wid = __builtin_amdgcn_readfirstlane(tid >> 6), qi = wid & 3, dvh = wid >> 2;
    const int trbase = ((lane >> 4) & 1) * 32 + (lane & 3) * 8 + (4 * hi + ((lane & 15) >> 2)) * 64;
    constexpr int NU = NB * RH * NC;
    const unsigned row0 = (unsigned)tid >> 3, chn = (unsigned)tid & 7;
    const unsigned vo_k = row0 * (RQW * 2) + chn * 16, vo_s = row0 * 128 + chn * 16, vo_v = (unsigned)(lane >> 4) * (RW * 2) + (unsigned)(lane & 15) * 16;
    const unsigned lo_k = chn * R3_CS + row0 * 16;
    v4u krv[2], qrv[2], sfv[2], sbv[2], vv[4]; f32x4 gwv = {0.f, 0.f, 0.f, 0.f}; float dsc[2][4];
#define R3_LOAD(uu) do { const int c_ = (uu) & 127, h_ = ((uu) >> 7) & 7, b_ = (uu) >> 10; const size_t t0_ = (size_t)b_ * SEQ + c_ * CH; \
        const size_t ko = t0_ * RQW + h_ * RDK; const bf16* sb_ = P.st + ((((size_t)(b_ * RH + h_) * NC + c_) * 2) * 8192); \
        _Pragma("unroll") for (int j = 0; j < 2; ++j) { \
            krv[j] = ldg16(P.kf + ko + j * 64 * RQW, vo_k); qrv[j] = ldg16(P.qf + ko + j * 64 * RQW, vo_k); \
            _Pragma("unroll") for (int kd = 0; kd < 4; ++kd) dsc[j][kd] = P.decT[kd * 1024 + h_ * 128 + row0 + 64 * j]; \
            sfv[j] = *(const v4u*)((const char*)(sb_ + j * 64 * 64) + vo_s); sbv[j] = *(const v4u*)((const char*)(sb_ + 8192 + j * 64 * 64) + vo_s); } \
        _Pragma("unroll") for (int i = 0; i < 4; ++i) vv[i] = ldg16(P.vr + (t0_ + (wid * 4 + i) * 4) * RW + h_ * RDV, vo_v); \
        if (tid < 32) gwv = *(const f32x4*)(P.gn_w + h_ * RDV + tid * 4); } while (0)
    if (vcu < NU) R3_LOAD(vcu);
    if (NGT > 0) attn_ra(P, gt, NGT);
    for (int u = vcu; u < NU; u += G) {
        const int c = u & 127, h = (u >> 7) & 7, b = u >> 10; const size_t t0 = (size_t)b * SEQ + c * CH;
        LDS_BAR();
#pragma unroll
        for (int j = 0; j < 2; ++j) { LAS unsigned char* d = lds + lo_k + j * 1024;
            *(LAS v4u*)(d + R3_QF) = scale8(qrv[j], dsc[j][0]); *(LAS v4u*)(d + R3_QB) = scale8(qrv[j], dsc[j][1]); *(LAS v4u*)(d + R3_KF) = scale8(krv[j], dsc[j][2]); *(LAS v4u*)(d + R3_KB) = scale8(krv[j], dsc[j][3]);
            *(LAS v4u*)(d + R3_SF) = sfv[j]; *(LAS v4u*)(d + R3_SB) = sbv[j]; }
#pragma unroll
        for (int i = 0; i < 4; ++i) { const int row = (wid * 4 + i) * 4 + (lane >> 4);
            *(LAS v4u*)(lds + R3_V + ((((lane & 15) >> 2) * 8 + (row >> 4)) * 1024) + (row & 15) * 64 + (lane & 3) * 16) = vv[i]; }
        if (tid < 32) ((LAS f32x4*)(lds + R3_GW))[tid] = gwv;
        LDS_BAR();
        const size_t tokb = t0 + qi * 32; const int colb = h * RDV + dvh * 64;
        v4u gv[4];
#pragma unroll
        for (int i = 0; i < 4; ++i) gv[i] = __builtin_nontemporal_load((const v4u*)(P.gr + (tokb + i * 8 + (lane >> 3)) * RW + colb + (lane & 7) * 8));
        if (u + G < NU) R3_LOAD(u + G);
        __builtin_amdgcn_sched_barrier(0);
        if (MODE == 2) { asm volatile("" :: "v"(gv[0]), "v"(gv[1]), "v"(gv[2]), "v"(gv[3])); continue; }
        const lds_cptr fb = (lds_cptr)lds + hi * R3_CS + r32 * 16;
        bf16x8 qff[4], qbf[4];
#pragma unroll
        for (int d0 = 0; d0 < 4; ++d0) { qff[d0] = *(const LAS bf16x8*)(fb + R3_QF + d0 * 2 * R3_CS + qi * 512); qbf[d0] = *(const LAS bf16x8*)(fb + R3_QB + d0 * 2 * R3_CS + qi * 512); }
        f32x16 o[2];
        o[0] = (f32x16){}; o[1] = (f32x16){};
#pragma unroll
        for (int dp = 0; dp < 2; ++dp) {
            bf16x8 sr[8];
#pragma unroll
            for (int dd = 0; dd < 2; ++dd)
#pragma unroll
                for (int dbl = 0; dbl < 2; ++dbl) { const int ro = (dvh * 2 + dbl) * 512 + (dp * 2 + dd) * 2 * R3_CS;
                    sr[dd * 4 + dbl * 2] = *(const LAS bf16x8*)(fb + R3_SF + ro); sr[dd * 4 + dbl * 2 + 1] = *(const LAS bf16x8*)(fb + R3_SB + ro); }
            __builtin_amdgcn_sched_barrier(0);
#pragma unroll
            for (int dd = 0; dd < 2; ++dd) { const int d0 = dp * 2 + dd;
                o[0] = MFMA32(sr[dd * 4 + 0], qff[d0], o[0]); o[1] = MFMA32(sr[dd * 4 + 2], qff[d0], o[1]);
                o[0] = MFMA32(sr[dd * 4 + 1], qbf[d0], o[0]); o[1] = MFMA32(sr[dd * 4 + 3], qbf[d0], o[1]); }
            __builtin_amdgcn_sched_barrier(0);
        }
        const lds_cptr vb = (lds_cptr)(lds + R3_V) + trbase;
#pragma unroll
        for (int kj = 0; kj < 4; ++kj) {
            f32x16 sf = {}, sbw = {};
            if (kj <= qi) {
                bf16x8 kr_[4];
#pragma unroll
                for (int d0 = 0; d0 < 4; ++d0) kr_[d0] = *(const LAS bf16x8*)(fb + R3_KF + d0 * 2 * R3_CS + kj * 512);
                __builtin_amdgcn_sched_barrier(0);
#pragma unroll
                for (int d0 = 0; d0 < 4; ++d0) sf = MFMA32(kr_[d0], qff[d0], sf);
            }
            if (kj >= qi) {
                bf16x8 kr_[4];
#pragma unroll
                for (int d0 = 0; d0 < 4; ++d0) kr_[d0] = *(const LAS bf16x8*)(fb + R3_KB + d0 * 2 * R3_CS + kj * 512);
                __builtin_amdgcn_sched_barrier(0);
#pragma unroll
                for (int d0 = 0; d0 < 4; ++d0) sbw = MFMA32(kr_[d0], qbf[d0], sbw);
            }
            f32x16 p;
#pragma unroll
            for (int r = 0; r < 16; ++r) p[r] = (kj < qi) ? sf[r] : (kj > qi) ? sbw[r] : ((crow(r, hi) <= r32) ? sf[r] : sbw[r]);
            const bf16x8 pw0 = PK8(p, 0), pw1 = PK8(p, 8);
            bf16x8 vf_[4];
#pragma unroll
            for (int dbl = 0; dbl < 2; ++dbl) { const int db = dvh * 2 + dbl; vf_[dbl * 2] = vtr8(vb + (db * 8 + kj * 2) * 1024); vf_[dbl * 2 + 1] = vtr8(vb + (db * 8 + kj * 2 + 1) * 1024); }
            __builtin_amdgcn_sched_barrier(0);
            o[0] = MFMA32(vf_[0], pw0, o[0]); o[1] = MFMA32(vf_[2], pw0, o[1]); o[0] = MFMA32(vf_[1], pw1, o[0]); o[1] = MFMA32(vf_[3], pw1, o[1]);
        }
        float s1 = 0.f, s2 = 0.f;
#pragma unroll
        for (int dbl = 0; dbl < 2; ++dbl)
#pragma unroll
            for (int r = 0; r < 16; ++r) { s1 += o[dbl][r]; s2 += o[dbl][r] * o[dbl][r]; }
        s1 = half_swap_sum(s1); s2 = half_swap_sum(s2);
        if (MODE == 1) { asm volatile("" :: "v"(s1), "v"(s2), "v"(gv[0]), "v"(gv[1]), "v"(gv[2]), "v"(gv[3])); LDS_BAR(); continue; }
        typedef float f32x2_t __attribute__((ext_vector_type(2)));
        LAS f32x2_t* xch = (LAS f32x2_t*)(lds + R3_XCH);
        if (hi == 0) xch[wid * 32 + r32] = (f32x2_t){s1, s2};
        LDS_BAR();
        { const f32x2_t pp = xch[(wid ^ 4) * 32 + r32]; s1 += pp.x; s2 += pp.y; }
        const float mu = s1 * (1.0f / RDV), var = fmaxf(s2 * (1.0f / RDV) - mu * mu, 0.f), rs = 1.0f / sqrtf(var + EPS);
        const LAS f32x4* gw = (const LAS f32x4*)(lds + R3_GW);
        LAS unsigned char* stg = lds + wid * 4096;
#pragma unroll
        for (int dbl = 0; dbl < 2; ++dbl)
#pragma unroll
            for (int rq = 0; rq < 4; ++rq) { const int cl = dbl * 32 + 8 * rq + 4 * hi; const f32x4 w = gw[(dvh * 64 + cl) >> 2];
                u32x2 ov; ov.x = cvtpk((o[dbl][4 * rq] - mu) * rs * w.x, (o[dbl][4 * rq + 1] - mu) * rs * w.y); ov.y = cvtpk((o[dbl][4 * rq + 2] - mu) * rs * w.z, (o[dbl][4 * rq + 3] - mu) * rs * w.w);
                *(LAS u32x2*)(stg + r32 * 128 + cl * 2) = ov; }
        asm volatile("s_waitcnt lgkmcnt(0)" ::: "memory");
        v4u sv[4];
#pragma unroll
        for (int i = 0; i < 4; ++i) { const int tk = i * 8 + (lane >> 3); sv[i] = *(const LAS v4u*)(stg + tk * 128 + (lane & 7) * 16); }
#pragma unroll
        for (int i = 0; i < 4; ++i) { const int tk = i * 8 + (lane >> 3); float a[8], g8[8], y[8]; unpack8(sv[i], a); unpack8(gv[i], g8);
#pragma unroll
            for (int k = 0; k < 8; ++k) y[k] = a[k] * g8[k];
            const v4u yv = pack8(y); if (MODE == 3) asm volatile("" :: "v"(yv)); else *(v4u*)(P.mix + (tokb + tk) * DM + AW + colb + (lane & 7) * 8) = yv; }
    }
#undef R3_LOAD
}
__device__ __forceinline__ void attn_ra(const Ptrs& P, int gt, int NGT) {
    for (int t = gt; t < T; t += NGT) { const f32x4* sp = (const f32x4*)(P.ssq + (size_t)t * 16); const f32x4 a = sp[0], b = sp[1], c = sp[2], d = sp[3];
        const float ss = ((a.x + a.y) + (a.z + a.w)) + ((b.x + b.y) + (b.z + b.w)) + ((c.x + c.y) + (c.z + c.w)) + ((d.x + d.y) + (d.z + d.w));
        P.ra[t] = 1.0f / sqrtf(ss * (1.0f / AW) + EPS); }
}
__device__ __forceinline__ void ret_scan(const Ptrs& P, int gt, int NGT) {
    for (int q = gt; q < NB * RH * 2 * 4096; q += NGT) {
        const int e2 = q & 4095, dir = (q >> 12) & 1, h = (q >> 13) & 7, b = q >> 16;
        const float gam = P.gam[dir * 8 + h];
        float S0 = 0.f, S1 = 0.f;
        const size_t base = (((size_t)(b * RH + h) * NC) * 2 + dir) * 8192 + e2 * 2;
        for (int c0 = 0; c0 < NC; c0 += 32) {
            unsigned g[32];
#pragma unroll
            for (int k = 0; k < 32; ++k) { const int c = dir ? (NC - 1 - (c0 + k)) : (c0 + k); g[k] = *(const unsigned*)(P.G + base + (size_t)c * 16384); }
#pragma unroll
            for (int k = 0; k < 32; ++k) { const int c = dir ? (NC - 1 - (c0 + k)) : (c0 + k);
                *(unsigned*)(P.st + base + (size_t)c * 16384) = pk2(S0, S1);
                S0 = (S0 + bflo(g[k])) * gam; S1 = (S1 + bfhi(g[k])) * gam; }
        }
    }
}
__device__ __forceinline__ void final_norm2(const Ptrs& P, int gw, int NGW, int lane, int r0, int nrows) {
    f32x4 wv[8];
    { const GAS f32x4* wr_ = (const GAS f32x4*)P.fin_w + lane;
#pragma unroll
      for (int j = 0; j < 8; ++j) wv[j] = wr_[64 * j]; }
    for (int mr = gw; mr < nrows; mr += 2 * NGW) {
        const int m = r0 + mr, m2 = m + NGW; const bool has2 = mr + NGW < nrows; const int mb = has2 ? m2 : m;
        const GAS f32x4* xa = (const GAS f32x4*)(P.x + (size_t)m * DM) + lane; const GAS f32x4* xb = (const GAS f32x4*)(P.x + (size_t)mb * DM) + lane;
        const GAS u32x2* da = (const GAS u32x2*)(P.dlt + (size_t)m * DM) + lane; const GAS u32x2* db = (const GAS u32x2*)(P.dlt + (size_t)mb * DM) + lane;
        f32x4 va[8], vb[8]; u32x2 ea[8], eb[8];
#pragma unroll
        for (int j = 0; j < 8; ++j) { va[j] = __builtin_nontemporal_load(xa + 64 * j); vb[j] = __builtin_nontemporal_load(xb + 64 * j); ea[j] = da[64 * j]; eb[j] = db[64 * j]; }
        float sa_ = 0.f, sb_ = 0.f;
#pragma unroll
        for (int j = 0; j < 8; ++j) {
            va[j].x += bflo(ea[j].x); va[j].y += bfhi(ea[j].x); va[j].z += bflo(ea[j].y); va[j].w += bfhi(ea[j].y);
            vb[j].x += bflo(eb[j].x); vb[j].y += bfhi(eb[j].x); vb[j].z += bflo(eb[j].y); vb[j].w += bfhi(eb[j].y);
            sa_ += (va[j].x * va[j].x + va[j].y * va[j].y) + (va[j].z * va[j].z + va[j].w * va[j].w); sb_ += (vb[j].x * vb[j].x + vb[j].y * vb[j].y) + (vb[j].z * vb[j].z + vb[j].w * vb[j].w); }
        const float ra_ = 1.0f / sqrtf(wave_sum(sa_) * (1.f / DM) + EPS), rb_ = 1.0f / sqrtf(wave_sum(sb_) * (1.f / DM) + EPS);
        GAS f32x4* oa = (GAS f32x4*)(P.out + (size_t)m * DM) + lane; GAS f32x4* ob = (GAS f32x4*)(P.out + (size_t)m2 * DM) + lane;
#pragma unroll
        for (int j = 0; j < 8; ++j) { const f32x4 w = wv[j]; f32x4 o; o.x = va[j].x * ra_ * w.x; o.y = va[j].y * ra_ * w.y; o.z = va[j].z * ra_ * w.z; o.w = va[j].w * ra_ * w.w; st16_aux(P.out + (size_t)m * DM, (unsigned)(lane * 16 + j * 1024), __builtin_bit_cast(v4u, o));
            if (has2) { f32x4 o2; o2.x = vb[j].x * rb_ * w.x; o2.y = vb[j].y * rb_ * w.y; o2.z = vb[j].z * rb_ * w.z; o2.w = vb[j].w * rb_ * w.w; st16_aux(P.out + (size_t)m2 * DM, (unsigned)(lane * 16 + j * 1024), __builtin_bit_cast(v4u, o2)); } }
    }
}

#ifndef STAGGER_TICKS
#define STAGGER_TICKS 250
#endif
#ifndef MK_N_LAUNCHES
#define MK_N_LAUNCHES 1
#endif
constexpr int N_PHASES = 7;
struct Args { const float* in[11]; float* out; unsigned char* ws; int ph_lo, ph_hi; };
__device__ __forceinline__ void make_ptrs(Ptrs& P, const Args& args) {
    unsigned char* ws = args.ws;
    P.x = args.in[0]; P.norm_w = args.in[1]; P.w_in = args.in[2]; P.sink = args.in[3]; P.rel_bias = args.in[4]; P.aon_w = args.in[5];
    P.dec_f = args.in[6]; P.dec_b = args.in[7]; P.gn_w = args.in[8]; P.w_out = args.in[9]; P.fin_w = args.in[10]; P.out = args.out;
    P.win_t = (bf16*)(ws + WS_WIN); P.wo_t = (bf16*)(ws + WS_WO); P.xn = (bf16*)(ws + WS_XN); P.mix = (bf16*)(ws + WS_MIX);
    P.qa = (bf16*)(ws + WS_QA); P.ka = (bf16*)(ws + WS_KA); P.va = (bf16*)(ws + WS_VA); P.ga = (bf16*)(ws + WS_GA);
    P.qf = (bf16*)(ws + WS_QF); P.qb = (bf16*)(ws + WS_QB); P.kf = (bf16*)(ws + WS_KF); P.kb = (bf16*)(ws + WS_KB);
    P.vr = (bf16*)(ws + WS_VR); P.gr = (bf16*)(ws + WS_GR); P.st = (bf16*)(ws + WS_ST); P.dlt = (bf16*)(ws + WS_DLT);
    P.cosT = (float*)(ws + WS_COS); P.sinT = (float*)(ws + WS_SIN); P.decT = (float*)(ws + WS_DEC); P.biasT = (float*)(ws + WS_BIAS);
    P.sink2 = (float*)(ws + WS_SINK); P.gam = (float*)(ws + WS_GAM); P.ssq = (float*)(ws + WS_SSQ); P.ra = (float*)(ws + WS_SSQ + 2 * MiB); P.G = (bf16*)(ws + WS_G);

}
__global__ void __launch_bounds__(NWAVES * 64, 2) hymba_fwd(Args args) {
    extern __shared__ __attribute__((aligned(16))) unsigned char lds_raw[];
    LAS unsigned char* lds = (LAS unsigned char*)lds_raw;
    volatile LAS unsigned* MISC = (volatile LAS unsigned*)(lds + MISC_OFF);
    const int tid = threadIdx.x, lane = tid & 63, wave = __builtin_amdgcn_readfirstlane(tid >> 6);
    const int G = gridDim.x, bx = blockIdx.x, vcu = (G % 8 == 0) ? (bx % 8) * (G / 8) + bx / 8 : bx;
    const int gw = vcu * NWAVES + wave, NGW = G * NWAVES, gt = gw * 64 + lane, NGT = NGW * 64;
    unsigned char* ws = args.ws;
    gu32* ctl = (gu32*)(ws + WS_CTL);
    for (int u = tid; u < (LDS_BYTES - LDSCTL_OFF) / 4; u += NWAVES * 64) ((LAS unsigned*)(lds + LDSCTL_OFF))[u] = 0u;
    __syncthreads();
    XcdBarrier bar; bar.bar = (unsigned*)(ctl + CW_BAR); bar.x = 0; bar.st = nullptr;
    if (MK_N_LAUNCHES == 1) bar = xcd_barrier_post((unsigned*)(ctl + CW_BAR), MISC + 8);
    const int lo = args.ph_lo, hi = args.ph_hi;
#ifndef TEST_PHASES
#define TEST_PHASES 127
#endif
#define IN(k) (((TEST_PHASES >> (k)) & 1) && lo <= (k) && (k) < hi)
#define SEAM(k) do { if (IN(k) && IN((k) + 1)) xcd_barrier(bar); } while (0)
#ifndef REPEAT_MASK
#define REPEAT_MASK 0
#endif
#define NREP(k) (((REPEAT_MASK >> (k)) & 1) ? 2 : 1)

    if (IN(0)) { Ptrs P; make_ptrs(P, args); for (int rep_ = 0; rep_ < NREP(0); ++rep_) p0_prologue(P, lds, gw, NGW, wave, lane); SEAM(0); }
    if (IN(1)) for (int rep_ = 0; rep_ < NREP(1); ++rep_) { Ptrs P; make_ptrs(P, args);
        pg8::Gemm g{P.xn, P.win_t, T, INW, DM}; pg8::StaticOrder S; S.init(T, INW, G, bx);
        EpiIn E{P.qa, P.ka, P.va, P.ga, P.qf, P.qb, P.kf, P.kb, P.vr, P.gr, P.cosT, P.sinT, P.decT};
        pg8::gemm_phase<EpiIn, pg8::StaticOrder, true, true>(lds + RING_OFF, g, S, E);
        if (rep_ == NREP(1) - 1) SEAM(1);
    }
    if (IN(2)) { Ptrs P; make_ptrs(P, args); for (int rep_ = 0; rep_ < NREP(8); ++rep_) ret_kv_phase(P, lds, vcu, G); SEAM(2); }
    if (IN(3)) { Ptrs P; make_ptrs(P, args); attn_phase(P, lds, vcu, G, gt, NGT); SEAM(3); }
    if (IN(4)) { Ptrs P; make_ptrs(P, args); ret_out_phase<0>(P, lds, vcu, G, gt, NGT); if (NREP(4) > 1) ret_out_phase<0>(P, lds, vcu, G); if (NREP(11) > 1) ret_out_phase<1>(P, lds, vcu, G); if (NREP(12) > 1) ret_out_phase<2>(P, lds, vcu, G); if (NREP(13) > 1) ret_out_phase<3>(P, lds, vcu, G); SEAM(4); }
    if (IN(5)) { Ptrs P; make_ptrs(P, args);
        const bool grpA = (vcu & 1) == 0; const int nA = (G + 1) / 2, nB = G / 2, grank = vcu >> 1;
        const int gwl = grank * NWAVES + wave, ngwl = (grpA ? nA : nB) * NWAVES;
        const int rowsA = (G > 1) ? SEQ / 2 : SEQ;
        { pg8::Gemm g{P.mix, P.wo_t, SEQ, DM, DM}; pg8::StaticOrder S; S.init(SEQ, DM, G, bx); EpiDelta E{P.dlt, P.ra};
          pg8::gemm_phase<EpiDelta, pg8::StaticOrder, true, true>(lds + RING_OFF, g, S, E); }
        if (MK_N_LAUNCHES == 1) xcd_barrier(bar);
        if (grpA) final_norm2(P, gwl, ngwl, lane, 0, rowsA);
        { pg8::Gemm g{P.mix + (size_t)SEQ * DM, P.wo_t, SEQ, DM, DM}; pg8::StaticOrder S; S.init(SEQ, DM, G, bx); EpiDelta E{P.dlt + (size_t)SEQ * DM, P.ra + SEQ};
          pg8::gemm_phase<EpiDelta, pg8::StaticOrder, true, true>(lds + RING_OFF, g, S, E); }
        if (!grpA) final_norm2(P, gwl, ngwl, lane, rowsA, SEQ - rowsA);
        SEAM(5);
    }
    if (IN(6)) { Ptrs P; make_ptrs(P, args); final_norm2(P, gw, NGW, lane, SEQ, SEQ); }
#undef IN
#undef SEAM
}

extern "C" void kernel_launch(void* const* d_in, const int* in_sizes, int n_in, void* d_out, int out_size, void* d_ws, size_t ws_size, hipStream_t stream) {
    static int grid = 0;
    if (grid == 0) {
        if (n_in != 11 || in_sizes[0] != T * DM || out_size != T * DM || ws_size < WS_END) {
            fprintf(stderr, "kernel_launch: unexpected shapes: n_in %d in0 %d out %d ws %zu (need %zu)\n", n_in, n_in > 0 ? in_sizes[0] : -1, out_size, ws_size, (size_t)WS_END); grid = -1; return; }
        int dev = 0, cus = 0;
        if (hipGetDevice(&dev) != hipSuccess || hipDeviceGetAttribute(&cus, hipDeviceAttributeMultiprocessorCount, dev) != hipSuccess) { grid = -1; return; }
        if (hipFuncSetAttribute((const void*)hymba_fwd, hipFuncAttributeMaxDynamicSharedMemorySize, LDS_BYTES) != hipSuccess) { fprintf(stderr, "kernel_launch: hipFuncSetAttribute failed\n"); grid = -1; return; }
        int per_cu = 0;
        if (hipOccupancyMaxActiveBlocksPerMultiprocessor(&per_cu, (const void*)hymba_fwd, NWAVES * 64, LDS_BYTES) != hipSuccess || per_cu < 1)
            fprintf(stderr, "kernel_launch: occupancy query reports %d blocks per CU\n", per_cu);
        (void)hipGetLastError();
        grid = cus;
    }
    if (grid < 0) return;
    (void)hipMemsetAsync((char*)d_ws + WS_CTL, 0, CTL_ZERO_BYTES, stream);
    Args a{};
    for (int i = 0; i < 11; ++i) a.in[i] = (const float*)d_in[i];
    a.out = (float*)d_out; a.ws = (unsigned char*)d_ws;
    if (MK_N_LAUNCHES == 1) { a.ph_lo = 0; a.ph_hi = N_PHASES; hipLaunchKernelGGL(hymba_fwd, dim3(grid), dim3(NWAVES * 64), LDS_BYTES, stream, a); }
    else for (int li = 0; li < N_PHASES; ++li) { a.ph_lo = li; a.ph_hi = li + 1; hipLaunchKernelGGL(hymba_fwd, dim3(grid), dim3(NWAVES * 64), LDS_BYTES, stream, a); }
}
```

```cpp
#include <hip/hip_runtime.h>
#include <cstdio>
#include <cstdint>
namespace pg8 {
#define PG8_LAS __attribute__((address_space(3)))
typedef unsigned short bf16_t;
typedef short bf16x8 __attribute__((ext_vector_type(8)));
typedef float f32x4 __attribute__((ext_vector_type(4)));
typedef unsigned u32x4 __attribute__((ext_vector_type(4)));
constexpr int BM = 256, BK = 64, HALF = 128, HTB = HALF * BK * 2  , STAGE_BYTES = 8 * HTB, NXCD = 8, WGM = 8;

__host__ __device__ __forceinline__ int lds_byte(int r, int c) { const int st = (r >> 4) * 2 + (c >> 5), rr = r & 15, cc = c & 31, ob = rr * 64 + cc * 2; return st * 1024 + (ob ^ (((ob >> 9) & 1) << 5)); }
__host__ __device__ __forceinline__ void stage_rc(int b, int& R, int& C) { const int st = b / 1024, sb = b % 1024, swz = sb ^ (((sb >> 9) & 1) << 5); R = (st >> 1) * 16 + swz / 64; C = (st & 1) * 32 + (swz % 64) / 2; }
__host__ __device__ __forceinline__ int perm32(int rho) { const int n = rho >> 4, i = rho & 15; return 8 * (i >> 2) + 4 * n + (i & 3); }

struct Unit { int pm, pn; };
struct Gemm { const bf16_t* A; const bf16_t* Bt; int M, N, K; };

struct StaticOrder {
    int nM, nN, nwg, G, c;
    __host__ __device__ void init(int M, int N, int G_, int c_) { nM = M / BM; nN = N / BM; nwg = nM * nN; G = G_; c = c_; }
    __host__ __device__ bool next(int i, Unit& u) const {
        const long L = (long)i * G + c; if (L >= nwg) return false;
        int wgid = (int)L; { const int q = nwg / NXCD, r = nwg % NXCD, xcd = wgid % NXCD, off = wgid / NXCD; wgid = (xcd < r ? xcd * (q + 1) : r * (q + 1) + (xcd - r) * q) + off; }
        const int nig = WGM * nN, gid = wgid / nig, fm = gid * WGM, gsz = (nM - fm) < WGM ? (nM - fm) : WGM;
        u.pm = fm + ((wgid % nig) % gsz); u.pn = (wgid % nig) / gsz; return true;
    }
    __device__ __forceinline__ void a_ready(const Unit&) const {}
    __device__ __forceinline__ void done(const Unit&) const {}
};

__device__ __forceinline__ unsigned cvt_pk_bf16(float lo, float hi) { unsigned r; asm volatile("v_cvt_pk_bf16_f32 %0, %1, %2" : "=v"(r) : "v"(lo), "v"(hi)); return r; }
typedef float f32x2 __attribute__((ext_vector_type(2)));
template <class Epi, class Sched, bool ALIGN_EPI = false, bool SP2 = false>
__device__ __forceinline__ void gemm_phase(PG8_LAS unsigned char* lds, const Gemm g, const Sched& S, const Epi& E) {
    const int tid = threadIdx.x, wid = __builtin_amdgcn_readfirstlane(tid >> 6), lane = tid & 63, wr = wid >> 2, wc = wid & 3, fr = lane & 15, fq = lane >> 4;
    const int K = g.K, nt = K / BK;
    unsigned voffA[2], voffB[2];
#pragma unroll
    for (int i = 0; i < 2; ++i) { int R, C; stage_rc(tid * 16 + i * 8192, R, C); const int Rb = Epi::PERM ? ((R & ~31) + perm32(R & 31)) : R;
        voffA[i] = (unsigned)(R * K + C) * 2u; voffB[i] = (unsigned)(Rb * K + C) * 2u; }
    const size_t kstep = (size_t)(BK * 2);
    const size_t hstep = (size_t)HALF * K * 2;
    const size_t tstep = 2 * hstep;
    const unsigned ldsw = (unsigned)wid * 1024u;
    const int aoff = lds_byte(wr * 64 + fr, fq * 8), boff = lds_byte(wc * 32 + fr, fq * 8);
#define PG8_SA(b, h) (((b) * 2 + (h)) * HTB)
#define PG8_SB(b, h) ((4 + (b) * 2 + (h)) * HTB)
#define PG8_STAGE(bufoff, gbase, voff) do { _Pragma("unroll") for (int _i = 0; _i < 2; ++_i) \
        __builtin_amdgcn_global_load_lds((const unsigned*)((const char*)(gbase) + (voff)[_i]), (PG8_LAS unsigned*)(lds + (bufoff) + ldsw + _i * 8192), 16, 0, 0); } while (0)
#define PG8_LDA(dst, b, h) do { _Pragma("unroll") for (int m = 0; m < 4; ++m) _Pragma("unroll") for (int k = 0; k < 2; ++k) dst[m][k] = *(const PG8_LAS bf16x8*)(lds + PG8_SA(b, h) + aoff + m * 2048 + k * 1024); } while (0)
#define PG8_LDB(dst, b, h) do { _Pragma("unroll") for (int n = 0; n < 2; ++n) _Pragma("unroll") for (int k = 0; k < 2; ++k) dst[n][k] = *(const PG8_LAS bf16x8*)(lds + PG8_SB(b, h) + boff + n * 2048 + k * 1024); } while (0)
#define PG8_MMA(ai, bj, At, Bt) do { __builtin_amdgcn_s_setprio(1); _Pragma("unroll") for (int m = 0; m < 4; ++m) _Pragma("unroll") for (int n = 0; n < 2; ++n) _Pragma("unroll") for (int k = 0; k < 2; ++k) \
        acc[ai][bj][m][n] = __builtin_amdgcn_mfma_f32_16x16x32_bf16(Bt[n][k], At[m][k], acc[ai][bj][m][n], 0, 0, 0); __builtin_amdgcn_s_setprio(0); } while (0)
#define PG8_WAIT_V(n) asm volatile("s_waitcnt vmcnt(" #n ")" ::: "memory")
#define PG8_WAIT_V_SEL(f) asm volatile("v_readfirstlane_b32 s100, %0\n\ts_nop 4\n\ts_cmp_lg_u32 s100, 0\n\ts_cbranch_scc0 .Lpgw%=a\n\ts_waitcnt vmcnt(24)\n\ts_branch .Lpgw%=b\n.Lpgw%=a:\n\ts_waitcnt vmcnt(8)\n.Lpgw%=b:" :: "v"(f) : "memory", "scc", "s100")
#define PG8_WAIT_L(n) asm volatile("s_waitcnt lgkmcnt(" #n ")" ::: "memory")
#define PG8_BAR __builtin_amdgcn_s_barrier()
#define PG8_SCHED __builtin_amdgcn_sched_barrier(0)
    Unit cur, nxt; int ui = 0;
    if (!S.next(0, cur)) return;
    f32x4 acc[2][2][4][2];
#pragma unroll
    for (int a = 0; a < 2; ++a)
#pragma unroll
        for (int b = 0; b < 2; ++b)
#pragma unroll
            for (int m = 0; m < 4; ++m)
#pragma unroll
                for (int n = 0; n < 2; ++n) acc[a][b][m][n] = (f32x4){0.f, 0.f, 0.f, 0.f};
    bf16x8 At[4][2], B0[2][2], B1[2][2];
    const char* cA = (const char*)g.A + (size_t)cur.pm * tstep; const char* cB = (const char*)g.Bt + (size_t)cur.pn * tstep;
    S.a_ready(cur);
    if constexpr (SP2) {
        PG8_STAGE(PG8_SB(0, 0), cB, voffB); PG8_STAGE(PG8_SB(0, 1), cB + hstep, voffB); PG8_STAGE(PG8_SA(0, 0), cA, voffA); PG8_STAGE(PG8_SA(0, 1), cA + hstep, voffA);
        if (wr == 1) PG8_BAR;
        PG8_WAIT_V(2); PG8_BAR;
        PG8_STAGE(PG8_SB(1, 0), cB + kstep, voffB); PG8_STAGE(PG8_SA(1, 0), cA + kstep, voffA); PG8_STAGE(PG8_SB(1, 1), cB + hstep + kstep, voffB);
        PG8_WAIT_V(6); PG8_BAR;
    } else {
        PG8_STAGE(PG8_SB(0, 0), cB, voffB); PG8_STAGE(PG8_SA(0, 0), cA, voffA); PG8_STAGE(PG8_SB(0, 1), cB + hstep, voffB); PG8_STAGE(PG8_SA(0, 1), cA + hstep, voffA);
        if (wr == 1) PG8_BAR;
        PG8_WAIT_V(4); PG8_BAR;
        PG8_STAGE(PG8_SB(1, 0), cB + kstep, voffB); PG8_STAGE(PG8_SA(1, 0), cA + kstep, voffA); PG8_STAGE(PG8_SB(1, 1), cB + hstep + kstep, voffB);
        PG8_WAIT_V(6); PG8_BAR;
    }
    for (;;) {
        const bool has_next = S.next(ui + 1, nxt);
        const char* nA = has_next ? (const char*)g.A + (size_t)nxt.pm * tstep : cA; const char* nB = has_next ? (const char*)g.Bt + (size_t)nxt.pn * tstep : cB;
        for (int t = 0; t < nt; t += 2) {
            const bool last = (t == nt - 2);
            const int rlx = (Epi::EPI_STORES >= 16 && t == 0 && ui > 0) ? 1 : 0;
            if constexpr (Epi::SCALE_AT >= 0) { if (t == Epi::SCALE_AT) E.scale(acc, cur, wr, wc, fr, fq); }
            const char* a1 = cA + (size_t)(t + 1) * kstep;
            const char* a2 = last ? nA : cA + (size_t)(t + 2) * kstep; const char* b2 = last ? nB : cB + (size_t)(t + 2) * kstep;
            const char* a3 = a2 + kstep; const char* b3 = b2 + kstep;
            if (last && has_next) S.a_ready(nxt);
            if constexpr (SP2) {
            PG8_LDB(B0, 0, 0); PG8_LDB(B1, 0, 1); PG8_SCHED; PG8_LDA(At, 0, 0); PG8_STAGE(PG8_SA(1, 1), a1 + hstep, voffA);
            PG8_WAIT_V_SEL(rlx); PG8_WAIT_L(0); PG8_BAR; PG8_MMA(0, 0, At, B0); PG8_MMA(0, 1, At, B1); PG8_BAR; PG8_SCHED;
            PG8_LDA(At, 0, 1); PG8_STAGE(PG8_SB(0, 0), b2, voffB); PG8_STAGE(PG8_SB(0, 1), b2 + hstep, voffB); PG8_STAGE(PG8_SA(0, 0), a2, voffA);
            PG8_WAIT_V_SEL(rlx); PG8_WAIT_L(0); PG8_BAR; PG8_MMA(1, 0, At, B0); PG8_MMA(1, 1, At, B1); PG8_BAR; PG8_SCHED;
            PG8_LDB(B0, 1, 0); PG8_LDB(B1, 1, 1); PG8_SCHED; PG8_LDA(At, 1, 0); PG8_STAGE(PG8_SA(0, 1), a2 + hstep, voffA);
            PG8_WAIT_V(8); PG8_WAIT_L(0); PG8_BAR; PG8_MMA(0, 0, At, B0); PG8_MMA(0, 1, At, B1); PG8_BAR; PG8_SCHED;
            PG8_LDA(At, 1, 1); PG8_STAGE(PG8_SB(1, 0), b3, voffB); PG8_STAGE(PG8_SB(1, 1), b3 + hstep, voffB); PG8_STAGE(PG8_SA(1, 0), a3, voffA);
            PG8_WAIT_V(8); PG8_WAIT_L(0); PG8_BAR; PG8_MMA(1, 0, At, B0); PG8_MMA(1, 1, At, B1); PG8_BAR; PG8_SCHED;
            } else {
            PG8_LDB(B0, 0, 0); PG8_SCHED; PG8_LDA(At, 0, 0); PG8_STAGE(PG8_SA(1, 1), a1 + hstep, voffA);
            PG8_WAIT_L(8); PG8_BAR; PG8_WAIT_L(0); PG8_MMA(0, 0, At, B0); PG8_BAR; PG8_SCHED;
            PG8_LDB(B1, 0, 1); PG8_STAGE(PG8_SB(0, 0), b2, voffB);
            PG8_BAR; PG8_WAIT_L(0); PG8_MMA(0, 1, At, B1); PG8_BAR;
            PG8_LDA(At, 0, 1); PG8_STAGE(PG8_SA(0, 0), a2, voffA);
            PG8_BAR; PG8_WAIT_L(0); PG8_MMA(1, 0, At, B0); PG8_BAR; PG8_SCHED;
            PG8_STAGE(PG8_SB(0, 1), b2 + hstep, voffB);
            PG8_WAIT_V(6); PG8_BAR; PG8_MMA(1, 1, At, B1); PG8_BAR;
            PG8_LDB(B0, 1, 0); PG8_SCHED; PG8_LDA(At, 1, 0); PG8_STAGE(PG8_SA(0, 1), a2 + hstep, voffA);
            PG8_WAIT_L(8); PG8_BAR; PG8_WAIT_L(0); PG8_MMA(0, 0, At, B0); PG8_BAR; PG8_SCHED;
            PG8_LDB(B1, 1, 1); PG8_STAGE(PG8_SB(1, 0), b3, voffB);
            PG8_BAR; PG8_WAIT_L(0); PG8_MMA(0, 1, At, B1); PG8_BAR;
            PG8_LDA(At, 1, 1); PG8_STAGE(PG8_SA(1, 0), a3, voffA);
            PG8_BAR; PG8_WAIT_L(0); PG8_MMA(1, 0, At, B0); PG8_BAR; PG8_SCHED;
            PG8_STAGE(PG8_SB(1, 1), b3 + hstep, voffB);
            PG8_WAIT_V(6); PG8_BAR; PG8_MMA(1, 1, At, B1); PG8_BAR;
            }
        }
        if constexpr (ALIGN_EPI) { if (wr == 0) PG8_BAR; }
        if constexpr (!Epi::AFTER_DRAIN) { E(acc, cur, wr, wc, fr, fq); S.done(cur); }
        if (!has_next) break;
#pragma unroll
        for (int a = 0; a < 2; ++a)
#pragma unroll
            for (int b = 0; b < 2; ++b)
#pragma unroll
                for (int m = 0; m < 4; ++m)
#pragma unroll
                    for (int n = 0; n < 2; ++n) acc[a][b][m][n] = (f32x4){0.f, 0.f, 0.f, 0.f};
        cur = nxt; cA = nA; cB = nB; ++ui;
        if constexpr (ALIGN_EPI) { if (wr == 1) PG8_BAR; }
    }
    PG8_WAIT_V(0);
    if constexpr (!ALIGN_EPI) { if (wr == 0) PG8_BAR; }
    PG8_BAR;
    if constexpr (Epi::AFTER_DRAIN) { E.fused(acc, cur, wr, wc, fr, fq, lds, wid, lane); S.done(cur); }
#undef PG8_SA
#undef PG8_SB
#undef PG8_STAGE
#undef PG8_LDA
#undef PG8_LDB
#undef PG8_MMA
#undef PG8_WAIT_V
#undef PG8_WAIT_L
#undef PG8_BAR
#undef PG8_SCHED
}
}
#define GAS __attribute__((address_space(1)))
#define LAS __attribute__((address_space(3)))
typedef unsigned short bf16;
typedef unsigned v4u __attribute__((ext_vector_type(4)));
typedef float f32x4 __attribute__((ext_vector_type(4)));
typedef short bf16x8 __attribute__((ext_vector_type(8)));
typedef GAS unsigned gu32;
typedef GAS unsigned long long gu64;
#define RLX_AGENT __ATOMIC_RELAXED, __HIP_MEMORY_SCOPE_AGENT
#define LDS_WAIT() asm volatile("s_waitcnt lgkmcnt(0)" ::: "memory")
#define VM_WAIT() asm volatile("s_waitcnt vmcnt(0)" ::: "memory")
__device__ __forceinline__ unsigned long long rt() { return __builtin_amdgcn_s_memrealtime(); }
__device__ __forceinline__ unsigned f2bf(float f) { unsigned u = __builtin_bit_cast(unsigned, f); return (u + 0x7fffu + ((u >> 16) & 1u)) >> 16; }
__device__ __forceinline__ unsigned pk2(float lo, float hi) { return f2bf(lo) | (f2bf(hi) << 16); }

constexpr int NB = 2, SEQ = 16384, T = NB * SEQ, DM = 2048, INW = 5632;
constexpr int AH = 16, AHD = 64, AW = 1024, AKW = 256;
constexpr int RH = 8, RDK = 64, RDV = 128, RQW = 512, RW = 1024, CH = 128, NC = SEQ / CH;
constexpr float EPS = 1e-6f, LOG2E = 1.4426950408889634f;
constexpr int BIAS_LD = 260;
constexpr int NWAVES = 8;

constexpr size_t MiB = 1u << 20;
constexpr size_t WS_CTL = 0, CTL_ZERO_BYTES = 32768;
constexpr size_t WS_COS = 1 * MiB, WS_SIN = 3 * MiB;
constexpr size_t WS_DEC = 5 * MiB;
constexpr size_t WS_BIAS = 5 * MiB + 65536;
constexpr size_t WS_SINK = 5 * MiB + 131072;
constexpr size_t WS_GAM = 5 * MiB + 131072 + 256;
constexpr size_t WS_WIN = 8 * MiB;
constexpr size_t WS_WO = 30 * MiB;
constexpr size_t WS_XN = 40 * MiB;
constexpr size_t WS_MIX = WS_XN;
constexpr size_t WS_QA = 168 * MiB, WS_KA = 232 * MiB, WS_VA = 248 * MiB, WS_GA = 264 * MiB;
constexpr size_t WS_QF = 328 * MiB, WS_QB = 360 * MiB, WS_KF = 392 * MiB, WS_KB = 424 * MiB, WS_VR = 456 * MiB, WS_GR = 520 * MiB;
constexpr size_t WS_SSQ = 648 * MiB;
constexpr size_t WS_G = 652 * MiB;
constexpr size_t WS_ST = 780 * MiB;
constexpr size_t WS_DLT = 848 * MiB;
constexpr size_t WS_END = 976 * MiB;
constexpr int CW_TMO = 0, CW_CODE = 1, CW_BAR = 4096;

constexpr int RING_OFF = 0, RING_BYTES = 131072;
constexpr int LDSCTL_OFF = 139264, MISC_OFF = LDSCTL_OFF + 320;
constexpr int LDS_BYTES = 147456;
#define XB_TMO      128
#define XB_XCNT(j)  (256  + 64 * (j))
#define XB_XSUB(j)  (1280 + 64 * (j))
#define XB_XGEN(j)  (2304 + 64 * (j))
#define XB_TOP      3328
#define XB_TOPGEN   3392
#define XCD_BAR_WORDS 3456
#define XB_SPIN_CAP (1u << 24)

__device__ __forceinline__ unsigned xb_ld(unsigned* p)              { return __hip_atomic_load(p, __ATOMIC_RELAXED, __HIP_MEMORY_SCOPE_AGENT); }
__device__ __forceinline__ unsigned xb_add(unsigned* p, unsigned v) { return __hip_atomic_fetch_add(p, v, __ATOMIC_RELAXED, __HIP_MEMORY_SCOPE_AGENT); }
__device__ __forceinline__ unsigned xb_xcc_id() { return (unsigned)__builtin_amdgcn_s_getreg((3 << 11) | 20) & 0xFu; }
#define XB_SPIN(cond, bar) do { unsigned _sp = 0; while (cond) { __builtin_amdgcn_s_sleep(1); \
    if ((++_sp & 255u) == 0u) { if (xb_ld(&(bar)[XB_TMO])) break; if (_sp > XB_SPIN_CAP) { atomicAdd(&(bar)[XB_TMO], 1u); break; } } } } while (0)

struct XcdBarrier {
    unsigned* bar; unsigned x;
    volatile LAS unsigned* st;
};

__device__ __forceinline__ XcdBarrier xcd_barrier_post(unsigned* bar, volatile LAS unsigned* st) {
    XcdBarrier b; b.bar = bar; b.x = xb_xcc_id(); b.st = st;
    if (threadIdx.x == 0) (void)xb_add(&bar[XB_XCNT(b.x)], 1u);
    return b;
}
__device__ __forceinline__ void xcd_barrier_complete(unsigned* bar, unsigned x, unsigned& nloc, unsigned& nx) {
    const unsigned G = gridDim.x * gridDim.y * gridDim.z;
    unsigned sum, cnt, mine, sp = 0u;
    for (;;) {
        sum = 0u; cnt = 0u; mine = 0u;
#pragma unroll
        for (unsigned j = 0; j < 16; ++j) { const unsigned c = xb_ld(&bar[XB_XCNT(j)]); sum += c; cnt += (c > 0u) ? 1u : 0u; mine = (j == x) ? c : mine; }
        if (sum == G) break;
        __builtin_amdgcn_s_sleep(1);
        if ((++sp & 255u) == 0u) { if (xb_ld(&bar[XB_TMO])) break; if (sp > XB_SPIN_CAP) { atomicAdd(&bar[XB_TMO], 1u); break; } }
    }
    nloc = mine > 0u ? mine : 1u; nx = cnt > 0u ? cnt : 1u;
}

__device__ __forceinline__ void xcd_barrier(const XcdBarrier& b) {
    asm volatile("s_waitcnt vmcnt(0)" ::: "memory");
    __syncthreads();
    if (threadIdx.x == 0) {
        unsigned* bar = b.bar;
        __builtin_amdgcn_s_waitcnt(0);
        unsigned nloc = b.st[0], nx = b.st[1];
        if (nloc == 0u) { xcd_barrier_complete(bar, b.x, nloc, nx); b.st[0] = nloc; b.st[1] = nx; }
        const unsigned old = xb_add(&bar[XB_XSUB(b.x)], 1u);
        const unsigned gen = old / nloc;
        if (old + 1u == (gen + 1u) * nloc) {
            __builtin_amdgcn_fence(__ATOMIC_RELEASE, "agent");
            asm volatile("s_waitcnt vmcnt(0)" ::: "memory");
            const unsigned og = xb_add(&bar[XB_TOP], 1u);
            const unsigned tg = og / nx;
            if (og + 1u == (tg + 1u) * nx) xb_add(&bar[XB_TOPGEN], 1u);
            else XB_SPIN(xb_ld(&bar[XB_TOPGEN]) == tg, bar);
            __builtin_amdgcn_fence(__ATOMIC_ACQUIRE, "agent");
            xb_add(&bar[XB_XGEN(b.x)], 1u);
            asm volatile("s_waitcnt vmcnt(0)" ::: "memory");
        } else {
            XB_SPIN(xb_ld(&bar[XB_XGEN(b.x)]) == gen, bar);
            __builtin_amdgcn_fence(__ATOMIC_ACQUIRE, "agent");
            asm volatile("s_waitcnt vmcnt(0)" ::: "memory");
        }
    }
    __syncthreads();
}

struct Ptrs {
    const float *x, *norm_w, *w_in, *sink, *rel_bias, *aon_w, *dec_f, *dec_b, *gn_w, *w_out, *fin_w;
    float* out;
    bf16 *win_t, *wo_t, *xn, *mix, *qa, *ka, *va, *ga, *qf, *qb, *kf, *kb, *vr, *gr, *st, *dlt;
    float *cosT, *sinT, *decT, *biasT, *sink2, *gam, *ssq, *ra; bf16* G;
};
typedef unsigned u32x2 __attribute__((ext_vector_type(2)));
__device__ __forceinline__ float bflo(unsigned w) { return __builtin_bit_cast(float, w << 16); }
__device__ __forceinline__ float bfhi(unsigned w) { return __builtin_bit_cast(float, w & 0xffff0000u); }
__device__ __forceinline__ float bf2f(bf16 h) { return __builtin_bit_cast(float, (unsigned)h << 16); }
__device__ __forceinline__ float wave_sum(float v) {
#pragma unroll
    for (int o = 1; o < 64; o <<= 1) v += __shfl_xor(v, o);
    return v;
}
__device__ __forceinline__ float wave_max(float v) {
#pragma unroll
    for (int o = 1; o < 64; o <<= 1) v = fmaxf(v, __shfl_xor(v, o));
    return v;
}
__device__ __forceinline__ float silu_f(float v) { return v * __builtin_amdgcn_rcpf(1.0f + __builtin_amdgcn_exp2f(-v * LOG2E)); }
__device__ __forceinline__ void unpack8(const v4u w, float (&f)[8]) {
    f[0] = bflo(w.x); f[1] = bfhi(w.x); f[2] = bflo(w.y); f[3] = bfhi(w.y); f[4] = bflo(w.z); f[5] = bfhi(w.z); f[6] = bflo(w.w); f[7] = bfhi(w.w);
}
__device__ __forceinline__ v4u pack8(const float (&f)[8]) {
    v4u w; w.x = pg8::cvt_pk_bf16(f[0], f[1]); w.y = pg8::cvt_pk_bf16(f[2], f[3]); w.z = pg8::cvt_pk_bf16(f[4], f[5]); w.w = pg8::cvt_pk_bf16(f[6], f[7]); return w;
}

__device__ __forceinline__ v4u scale8(const v4u w, float sc) { float f[8]; unpack8(w, f);
#pragma unroll
    for (int k = 0; k < 8; ++k) f[k] *= sc;
    return pack8(f); }

__device__ __forceinline__ void p0_transpose_item(const float* W, int K, int N, bf16* WT, LAS float* scr, int item, int lane) {
    const int nblk = N / 32, kb = item / nblk, nb = item % nblk, k0 = 64 * kb, n0 = 32 * nb;
#pragma unroll 8
    for (int i = 0; i < 32; ++i) { const int kk = 2 * i + (lane >> 5); scr[kk * 33 + (lane & 31)] = __builtin_nontemporal_load(W + (size_t)(k0 + kk) * N + n0 + (lane & 31)); }
    LDS_WAIT(); asm volatile("" ::: "memory");
    const int c = lane & 7;
#pragma unroll
    for (int j = 0; j < 4; ++j) { const int n = (lane >> 3) + 8 * j; const LAS float* s = scr + (8 * c) * 33 + n;
        v4u o; o.x = pk2(s[0 * 33], s[1 * 33]); o.y = pk2(s[2 * 33], s[3 * 33]); o.z = pk2(s[4 * 33], s[5 * 33]); o.w = pk2(s[6 * 33], s[7 * 33]);
        *(GAS v4u*)(WT + (size_t)(n0 + n) * K + k0 + 8 * c) = o; }
    LDS_WAIT(); asm volatile("" ::: "memory");
}
__device__ __forceinline__ int t5_bucket(int rel) {
    const int n = rel < 0 ? -rel : rel; int b;
    if (n < 8) b = n; else if (n < 12) b = 8; else if (n < 16) b = 9; else if (n < 23) b = 10; else if (n < 32) b = 11;
    else if (n < 46) b = 12; else if (n < 64) b = 13; else if (n < 91) b = 14; else b = 15;
    return b + (rel > 0 ? 16 : 0);
}
__device__ __forceinline__ void p0_prologue(const Ptrs& P, LAS unsigned char* lds, int gw, int NGW, int wave, int lane) {
    LAS float* scr = (LAS float*)(lds + RING_OFF + wave * 16384);
    constexpr int I_IN = (DM / 64) * (INW / 32), I_OUT = (DM / 64) * (DM / 32);
    for (int it = gw; it < I_IN + I_OUT; it += NGW) {
        if (it < I_IN) p0_transpose_item(P.w_in, DM, INW, P.win_t, scr, it, lane);
        else p0_transpose_item(P.w_out, DM, DM, P.wo_t, scr, it - I_IN, lane);
    }
    {
        f32x4 wv[8];
        { const GAS f32x4* wr_ = (const GAS f32x4*)P.norm_w + lane;
#pragma unroll
          for (int j = 0; j < 8; ++j) wv[j] = wr_[64 * j]; }
        for (int m = gw; m < T; m += 2 * NGW) {
            const int m2 = m + NGW;
            const bool has2 = m2 < T;
            const GAS f32x4* xa = (const GAS f32x4*)(P.x + (size_t)m * DM) + lane; const GAS f32x4* xb = (const GAS f32x4*)(P.x + (size_t)(has2 ? m2 : m) * DM) + lane;
            f32x4 va[8], vb[8]; float sa_ = 0.f, sb_ = 0.f;
#pragma unroll
            for (int j = 0; j < 8; ++j) { va[j] = __builtin_nontemporal_load(xa + 64 * j); vb[j] = __builtin_nontemporal_load(xb + 64 * j); }
#pragma unroll
            for (int j = 0; j < 8; ++j) { sa_ += (va[j].x * va[j].x + va[j].y * va[j].y) + (va[j].z * va[j].z + va[j].w * va[j].w); sb_ += (vb[j].x * vb[j].x + vb[j].y * vb[j].y) + (vb[j].z * vb[j].z + vb[j].w * vb[j].w); }
            const float ra = 1.0f / sqrtf(wave_sum(sa_) * (1.f / DM) + EPS), rb = 1.0f / sqrtf(wave_sum(sb_) * (1.f / DM) + EPS);
            GAS u32x2* oa = (GAS u32x2*)(P.xn + (size_t)m * DM) + lane; GAS u32x2* ob = (GAS u32x2*)(P.xn + (size_t)m2 * DM) + lane;
#pragma unroll
            for (int j = 0; j < 8; ++j) { const f32x4 w = wv[j]; u32x2 o; o.x = pk2(va[j].x * ra * w.x, va[j].y * ra * w.y); o.y = pk2(va[j].z * ra * w.z, va[j].w * ra * w.w); oa[64 * j] = o;
                if (has2) { u32x2 o2; o2.x = pk2(vb[j].x * rb * w.x, vb[j].y * rb * w.y); o2.y = pk2(vb[j].z * rb * w.z, vb[j].w * rb * w.w); ob[64 * j] = o2; } }
        }
    }
    const int gt = gw * 64 + lane, NGT = NGW * 64;
    for (int idx = gt; idx < SEQ * 32; idx += NGT) {
        const int pos = idx >> 5, j = idx & 31;
        const float inv = exp2f(-((float)(2 * j) / 64.0f) * 13.287712379549449f);
        const float ang = (float)pos * inv;
        const double rev = (double)ang * 0.15915494309189535;
        const float fr = (float)(rev - floor(rev));
        P.cosT[idx] = __builtin_amdgcn_cosf(fr); P.sinT[idx] = __builtin_amdgcn_sinf(fr);
    }
    for (int idx = gt; idx < 4 * 8 * 128; idx += NGT) {
        const int kind = idx >> 10, h = (idx >> 7) & 7, i = idx & 127;
        const float lf = -log1pf(expf(-P.dec_f[h])), lb = -log1pf(expf(-P.dec_b[h]));
        float v;
        if (kind == 0) v = expf(lf * (float)i); else if (kind == 1) v = expf(-lb * (float)i);
        else if (kind == 2) v = expf(-lf * (float)i); else v = expf(lb * (float)i);
        P.decT[idx] = v;
    }
    for (int idx = gt; idx < 16 * BIAS_LD; idx += NGT) {
        const int h = idx / BIAS_LD, r = idx % BIAS_LD;
        P.biasT[idx] = (r <= 256) ? P.rel_bias[t5_bucket(r - 128) * 16 + h] * LOG2E : 0.f;
    }
    if (gt < 16) P.sink2[gt] = P.sink[gt] * LOG2E;
    if (gt < 16) { const int h = gt & 7; const float d = (gt < 8) ? P.dec_f[h] : P.dec_b[h]; P.gam[gt] = expf(-log1pf(expf(-d)) * 128.0f); }
}

#ifndef P1_ST_AUX
#define P1_ST_AUX 18
#endif
__device__ __forceinline__ void st16_aux(void* base, unsigned byte_off, const v4u v) {
    const __amdgpu_buffer_rsrc_t r = __builtin_amdgcn_make_buffer_rsrc((void*)base, (short)0, 0x7ffffff0, 0x00020000);
    __builtin_amdgcn_raw_buffer_store_b128(v, r, byte_off, 0, P1_ST_AUX);
}
struct EpiIn {
    static constexpr bool PERM = true, AFTER_DRAIN = false; static constexpr int SCALE_AT = -1, EPI_STORES = 16;
    bf16 *qa, *ka, *va, *ga, *qf, *qb, *kf, *kb, *vr, *gr; const float *cosT, *sinT, *decT;
    __device__ __forceinline__ void operator()(const pg8::f32x4 (&acc)[2][2][4][2], const pg8::Unit& u, int wr, int wc, int fr, int fq) const {
        const int pn = u.pn, row0 = u.pm * 256 + wr * 64 + fr, cl = wc * 32 + 8 * fq;
        if (pn >= 10 && pn < 14) {
            const bool isq = pn < 12; const int csec0 = (isq ? pn - 10 : pn - 12) * 256 + cl;
            bf16* oA = isq ? qf : kf; const float ksc = isq ? 1.0f : 0.125f;
#pragma unroll
            for (int ai = 0; ai < 2; ++ai) {
                f32x4 c4[4], s4[4];
                const int p0 = (csec0 & 63) >> 1;
#pragma unroll
                for (int m = 0; m < 4; ++m) { const int pos = (row0 + ai * 128 + m * 16) & (SEQ - 1); c4[m] = *(const f32x4*)(cosT + pos * 32 + p0); s4[m] = *(const f32x4*)(sinT + pos * 32 + p0); }
                __builtin_amdgcn_sched_barrier(0);
#pragma unroll
                for (int m = 0; m < 4; ++m) { const int row = row0 + ai * 128 + m * 16;
#pragma unroll
                    for (int bj = 0; bj < 2; ++bj) { const int csec = csec0 + bj * 128;
                        const pg8::f32x4 v0 = acc[ai][bj][m][0], v1 = acc[ai][bj][m][1]; const f32x4 cc = c4[m] * ksc, sn = s4[m] * ksc;
                        float y[8];
                        y[0] = v0[0] * cc[0] - v0[1] * sn[0]; y[1] = v0[0] * sn[0] + v0[1] * cc[0];
                        y[2] = v0[2] * cc[1] - v0[3] * sn[1]; y[3] = v0[2] * sn[1] + v0[3] * cc[1];
                        y[4] = v1[0] * cc[2] - v1[1] * sn[2]; y[5] = v1[0] * sn[2] + v1[1] * cc[2];
                        y[6] = v1[2] * cc[3] - v1[3] * sn[3]; y[7] = v1[2] * sn[3] + v1[3] * cc[3];
                        st16_aux(oA, (unsigned)(((size_t)row * RQW + csec) * 2), pack8(y)); } }
                __builtin_amdgcn_sched_barrier(0);
            }
        } else {
            bf16* base; int ldc, col0, mode;
            if (pn < 4) { base = qa; ldc = AW; col0 = pn * 256; mode = 1; }
            else if (pn == 4) { base = ka; ldc = AKW; col0 = 0; mode = 0; }
            else if (pn == 5) { base = va; ldc = AKW; col0 = 0; mode = 0; }
            else if (pn < 10) { base = ga; ldc = AW; col0 = (pn - 6) * 256; mode = 2; }
            else if (pn < 18) { base = vr; ldc = RW; col0 = (pn - 14) * 256; mode = 0; }
            else { base = gr; ldc = RW; col0 = (pn - 18) * 256; mode = 2; }
            const float sc = (mode == 1) ? 0.125f * LOG2E : 1.0f;
#pragma unroll
            for (int ai = 0; ai < 2; ++ai)
#pragma unroll
                for (int m = 0; m < 4; ++m) { const unsigned rowoff = (unsigned)(((size_t)(row0 + ai * 128 + m * 16) * ldc + col0 + cl) * 2);
#pragma unroll
                    for (int bj = 0; bj < 2; ++bj) { const pg8::f32x4 v0 = acc[ai][bj][m][0], v1 = acc[ai][bj][m][1];
                        float y[8] = {v0[0], v0[1], v0[2], v0[3], v1[0], v1[1], v1[2], v1[3]};
                        if (mode == 2) {
#pragma unroll
                            for (int k = 0; k < 8; ++k) y[k] = silu_f(y[k]);
                        } else {
#pragma unroll
                            for (int k = 0; k < 8; ++k) y[k] *= sc;
                        }
                        st16_aux(base, rowoff + bj * 256, pack8(y)); } }
        }
    }
};


struct EpiDelta {
    static constexpr bool PERM = true, AFTER_DRAIN = false; static constexpr int SCALE_AT = AW / 64, EPI_STORES = 16;
    bf16* dl; const float* ra;
    __device__ __forceinline__ void scale(pg8::f32x4 (&acc)[2][2][4][2], const pg8::Unit& u, int wr, int wc, int fr, int fq) const {
        const float* rp = ra + u.pm * 256 + wr * 64 + fr;
#pragma unroll
        for (int ai = 0; ai < 2; ++ai)
#pragma unroll
            for (int m = 0; m < 4; ++m) { const float r = rp[ai * 128 + m * 16];
#pragma unroll
                for (int bj = 0; bj < 2; ++bj)
#pragma unroll
                    for (int n = 0; n < 2; ++n) acc[ai][bj][m][n] *= r; }
    }
    __device__ __forceinline__ void operator()(const pg8::f32x4 (&acc)[2][2][4][2], const pg8::Unit& u, int wr, int wc, int fr, int fq) const {
        const int row0 = u.pm * 256 + wr * 64 + fr, col0 = u.pn * 256 + wc * 32 + 8 * fq;
#pragma unroll
        for (int ai = 0; ai < 2; ++ai)
#pragma unroll
            for (int m = 0; m < 4; ++m) { bf16* rowp = dl + (size_t)(row0 + ai * 128 + m * 16) * DM + col0;
#pragma unroll
                for (int bj = 0; bj < 2; ++bj) { const pg8::f32x4 v0 = acc[ai][bj][m][0], v1 = acc[ai][bj][m][1];
                    const float y[8] = {v0[0], v0[1], v0[2], v0[3], v1[0], v1[1], v1[2], v1[3]};
                    *(v4u*)(rowp + bj * 128) = pack8(y);     } }
    }
};
typedef float f32x16 __attribute__((ext_vector_type(16)));
typedef short s16x4 __attribute__((ext_vector_type(4)));
typedef short v4i16_t __attribute__((ext_vector_type(4)));
typedef LAS const char* lds_cptr;
__device__ __forceinline__ int crow(int r, int hi) { return (r & 3) + 8 * (r >> 2) + 4 * hi; }
__device__ __forceinline__ s16x4 vtr(lds_cptr p) { return __builtin_bit_cast(s16x4, __builtin_amdgcn_ds_read_tr16_b64_v4i16((LAS v4i16_t*)p)); }
__device__ __forceinline__ bf16x8 vtr8(lds_cptr p) { const s16x4 lo = vtr(p), hi_ = vtr(p + 512); return (bf16x8){lo[0], lo[1], lo[2], lo[3], hi_[0], hi_[1], hi_[2], hi_[3]}; }
__device__ __forceinline__ unsigned cvtpk(float lo, float hi) { typedef float f2_t __attribute__((ext_vector_type(2))); typedef __bf16 b2_t __attribute__((ext_vector_type(2))); f2_t v = {lo, hi}; b2_t b = __builtin_convertvector(v, b2_t); return __builtin_bit_cast(unsigned, b); }
__device__ __forceinline__ void half_swap(unsigned& a, unsigned& b) { asm volatile("s_nop 1\n\tv_permlane32_swap_b32 %0, %1" : "+v"(a), "+v"(b)); }
__device__ __forceinline__ float half_swap_max(float m) { unsigned a = __builtin_bit_cast(unsigned, m), b = a; half_swap(a, b); return fmaxf(__builtin_bit_cast(float, a), __builtin_bit_cast(float, b)); }
__device__ __forceinline__ float half_swap_sum(float m) { unsigned a = __builtin_bit_cast(unsigned, m), b = a; half_swap(a, b); return __builtin_bit_cast(float, a) + __builtin_bit_cast(float, b); }
#define LDS_BAR() asm volatile("s_waitcnt lgkmcnt(0)\n\ts_barrier" ::: "memory")
__device__ __forceinline__ float amax3(float a, float b, float c) { float r; asm("v_max3_f32 %0, %1, %2, %3" : "=v"(r) : "v"(a), "v"(b), "v"(c)); return r; }
#define MFMA32(a, b, c) __builtin_amdgcn_mfma_f32_32x32x16_bf16((a), (b), (c), 0, 0, 0)
#define PK8(p, B) __builtin_bit_cast(bf16x8, (v4u){cvtpk(p[B], p[B + 1]), cvtpk(p[B + 2], p[B + 3]), cvtpk(p[B + 4], p[B + 5]), cvtpk(p[B + 6], p[B + 7])})

constexpr int A_KT = 8192, A_KCS = 1040, A_KTS = 8 * A_KCS  , A_LK = 0, A_LV = 5 * A_KTS, A_LB = A_LV + 5 * A_KT, A_LWS = A_LB + 4 * 384 * 4, A_LOST = A_LWS + 8 * 64 * 4;
static_assert(A_LOST + 8 * 4096 <= RING_BYTES, "attention LDS map");
__device__ __forceinline__ void ret_scan(const Ptrs& P, int gt, int NGT);
__device__ __forceinline__ void attn_phase(const Ptrs& P, LAS unsigned char* lds, int vcu, int G, int gt, int NGT) {
    const int tid = threadIdx.x, lane = tid & 63, r32 = lane & 31, hi = lane >> 5, wid = __builtin_amdgcn_readfirstlane(tid >> 6), g = wid >> 1, sb = wid & 1;
    int cur_hk = -1;
    LAS float* wsf = (LAS float*)(lds + A_LWS) + wid * 64;
    constexpr int NU = NB * (SEQ / 64) * 4;
    v4u kreg[5], vreg[5]; bf16x8 qn[4];
#define ATT_LOAD(uu) do { const int hk_ = (uu) & 3, qb_ = ((uu) >> 2) & 255, b_ = (uu) >> 10, q0_ = qb_ * 64, tb_ = b_ * SEQ; \
        const int tlo_ = q0_ >= 128 ? 0 : (q0_ >= 64 ? 1 : 2); int thi_ = (SEQ + 128 - q0_) / 64; if (thi_ > 5) thi_ = 5; \
        const bf16* ksrc = P.ka + (size_t)(tb_ + q0_ - 128 + 8 * wid + (lane >> 3)) * AKW + hk_ * 64 + (lane & 7) * 8; \
        const bf16* vsrc = P.va + (size_t)(tb_ + q0_ - 128 + 8 * wid + (lane >> 3)) * AKW + hk_ * 64 + (lane & 7) * 8; \
        _Pragma("unroll") for (int t = 0; t < 5; ++t) if (t >= tlo_ && t < thi_) { kreg[t] = *(const v4u*)(ksrc + (size_t)t * 64 * AKW); vreg[t] = *(const v4u*)(vsrc + (size_t)t * 64 * AKW); } \
        } while (0)
#define ATT_LOADQ(uu) do { const int hk_ = (uu) & 3, qb_ = ((uu) >> 2) & 255, b_ = (uu) >> 10, q0_ = qb_ * 64, tb_ = b_ * SEQ; \
        const bf16* qp = P.qa + (size_t)(tb_ + q0_ + sb * 32 + r32) * AW + (hk_ * 4 + g) * 64 + hi * 8; \
        _Pragma("unroll") for (int d0 = 0; d0 < 4; ++d0) qn[d0] = __builtin_nontemporal_load((const bf16x8*)(qp + d0 * 16)); } while (0)
    if (vcu < NU) { ATT_LOAD(vcu); ATT_LOADQ(vcu); }
    ret_scan(P, gt, NGT);
    for (int u = vcu; u < NU; u += G) {
        const int hk = u & 3, qb = (u >> 2) & 255, b = u >> 10;
        const int q0 = qb * 64, tb = b * SEQ, h = hk * 4 + g;
        const int tlo = q0 >= 128 ? 0 : (q0 >= 64 ? 1 : 2);
        int thi = (SEQ + 128 - q0) / 64; if (thi > 5) thi = 5;
        LDS_BAR();
        if (hk != cur_hk) {
            for (int e = tid; e < 4 * 384; e += NWAVES * 64) { const int gg = e / 384, i = e % 384, r128 = i - 63;
                ((LAS float*)(lds + A_LB))[e] = (r128 >= 0 && r128 <= 256) ? P.biasT[(hk * 4 + gg) * BIAS_LD + r128] - P.sink2[hk * 4 + gg] : -1e30f; }
            cur_hk = hk;
        }
#pragma unroll
        for (int t = 0; t < 5; ++t) if (t >= tlo && t < thi) { const int row = 8 * wid + (lane >> 3), pc = lane & 7;
            *(LAS v4u*)(lds + A_LK + t * A_KTS + pc * A_KCS + row * 16) = kreg[t];
            *(LAS v4u*)(lds + A_LV + t * A_KT + ((pc >> 2) * 4 + (row >> 4)) * 1024 + (row & 15) * 64 + (pc & 3) * 16) = vreg[t]; }
        bf16x8 qr[4];
#pragma unroll
        for (int d0 = 0; d0 < 4; ++d0) qr[d0] = qn[d0];
        const float sink = P.sink2[h];
        LDS_BAR();
        v4u gv[4];
#pragma unroll
        for (int i = 0; i < 4; ++i) gv[i] = __builtin_nontemporal_load((const v4u*)(P.ga + (size_t)(tb + q0 + sb * 32 + i * 8 + (lane >> 3)) * AW + h * 64 + (lane & 7) * 8));
        const f32x4 aw0 = *(const f32x4*)(P.aon_w + h * 64 + (lane & 7) * 8), aw1 = *(const f32x4*)(P.aon_w + h * 64 + (lane & 7) * 8 + 4);
        if (u + G < NU) ATT_LOAD(u + G);
        float moff = 0.f, l = 0.f; f32x16 o0 = {}, o1 = {}; bool shifted = false;
        unsigned btoff = (unsigned)(size_t)((const LAS float*)(lds + A_LB) + g * 384 + 63 - (sb * 32 + r32) + 4 * hi) + 256u * (unsigned)tlo;
        asm volatile("" : "+v"(btoff));
        bool guard = false;
        f32x16 p0, p1;
#define ATT_CINIT() do { const LAS float* bb = (const LAS float*)(size_t)btoff; _Pragma("unroll") for (int r = 0; r < 16; ++r) { p0[r] = bb[(r & 3) + 8 * (r >> 2)]; p1[r] = bb[32 + (r & 3) + 8 * (r >> 2)]; } } while (0)
        ATT_CINIT();
#pragma unroll 1
        for (int t = tlo; t < thi;) {
            const lds_cptr kb_ = (lds_cptr)(lds + A_LK + t * A_KTS) + hi * A_KCS + r32 * 16;
            bf16x8 kf[8];
#pragma unroll
            for (int d0 = 0; d0 < 4; ++d0) { kf[2 * d0] = *(const LAS bf16x8*)(kb_ + d0 * 2 * A_KCS); kf[2 * d0 + 1] = *(const LAS bf16x8*)(kb_ + d0 * 2 * A_KCS + 512); }
            __builtin_amdgcn_sched_barrier(0);
#pragma unroll
            for (int d0 = 0; d0 < 4; ++d0) { p0 = MFMA32(kf[2 * d0], qr[d0], p0); p1 = MFMA32(kf[2 * d0 + 1], qr[d0], p1); }
            const lds_cptr vp = (lds_cptr)(lds + A_LV + t * A_KT) + ((lane >> 4) & 1) * 32 + (lane & 3) * 8 + (4 * hi + ((lane & 15) >> 2)) * 64;
            if (shifted) {
#pragma unroll
                for (int r = 0; r < 16; ++r) { p0[r] -= moff; p1[r] -= moff; }
            }
            if (guard) {
                float rm = amax3(p0[0], p1[0], p0[1]);
#pragma unroll
                for (int r = 1; r < 15; ++r) rm = amax3(rm, p1[r], p0[r + 1]);
                rm = amax3(rm, p1[15], rm);
                rm = half_swap_max(rm);
                if (__any(rm > 0.f)) {
                    const float dl = fmaxf(rm, 0.f), f = __builtin_amdgcn_exp2f(-dl); l *= f; moff += dl; shifted = true;
                    if (hi == 0) wsf[r32] = f;
#pragma unroll
                    for (int r = 0; r < 16; ++r) { const float fr_ = wsf[crow(r, hi)]; o0[r] *= fr_; o1[r] *= fr_; p0[r] -= dl; p1[r] -= dl; }
                }
            }
            float ps = 0.f;
#pragma unroll
            for (int r = 0; r < 16; ++r) { p0[r] = __builtin_amdgcn_exp2f(p0[r]); p1[r] = __builtin_amdgcn_exp2f(p1[r]); ps += p0[r] + p1[r]; }
            if (!guard && __any(!(ps <= 0x1p64f))) { guard = true; ATT_CINIT(); continue; }
            l += ps;
            const bf16x8 pa0 = PK8(p0, 0), pa1 = PK8(p0, 8), pa2 = PK8(p1, 0), pa3 = PK8(p1, 8);
            btoff += 256u; ++t;
            __builtin_amdgcn_sched_barrier(0);
            ATT_CINIT();
            bf16x8 vb[8];
#pragma unroll
            for (int i = 0; i < 4; ++i) { vb[2 * i] = vtr8(vp + i * 1024); vb[2 * i + 1] = vtr8(vp + 4096 + i * 1024); }
            __builtin_amdgcn_sched_barrier(0);
            o0 = MFMA32(pa0, vb[0], o0); o1 = MFMA32(pa0, vb[1], o1);
            o0 = MFMA32(pa1, vb[2], o0); o1 = MFMA32(pa1, vb[3], o1);
            o0 = MFMA32(pa2, vb[4], o0); o1 = MFMA32(pa2, vb[5], o1);
            o0 = MFMA32(pa3, vb[6], o0); o1 = MFMA32(pa3, vb[7], o1);
        }
#undef ATT_CINIT
        if (u + G < NU) ATT_LOADQ(u + G);
        l = half_swap_sum(l) + __builtin_amdgcn_exp2f(-moff);
        if (hi == 0) wsf[32 + r32] = 1.0f / l;
        LAS bf16* stg = (LAS bf16*)(lds + A_LOST) + wid * 2048;
#pragma unroll
        for (int r = 0; r < 16; ++r) { const int orow = crow(r, hi); const float il = wsf[32 + orow];
            stg[orow * 64 + r32] = (bf16)f2bf(o0[r] * il); stg[orow * 64 + 32 + r32] = (bf16)f2bf(o1[r] * il); }
        asm volatile("s_waitcnt lgkmcnt(0)" ::: "memory");
        bf16* ow = P.mix + (size_t)(tb + q0 + sb * 32) * DM + h * 64;
        const float awv[8] = {aw0.x, aw0.y, aw0.z, aw0.w, aw1.x, aw1.y, aw1.z, aw1.w};
        float ssv[4];
#pragma unroll
        for (int i = 0; i < 4; ++i) { const int row = i * 8 + (lane >> 3), ch = lane & 7; const v4u v = *(const LAS v4u*)(stg + row * 64 + ch * 8);
            float a[8], g8[8], y[8]; unpack8(v, a); unpack8(gv[i], g8); float ss = 0.f;
#pragma unroll
            for (int k = 0; k < 8; ++k) { ss += a[k] * a[k]; y[k] = a[k] * awv[k] * g8[k]; }
            ss += __shfl_xor(ss, 1); ss += __shfl_xor(ss, 2); ss += __shfl_xor(ss, 4); ssv[i] = ss;
            *(v4u*)(ow + (size_t)row * DM + ch * 8) = pack8(y); }
        if ((lane & 7) == 0) {
#pragma unroll
            for (int i = 0; i < 4; ++i) P.ssq[(size_t)(tb + q0 + sb * 32 + i * 8 + (lane >> 3)) * 16 + h] = ssv[i];
        }
    }
#undef ATT_LOAD
#undef ATT_LOADQ
}
__device__ __forceinline__ v4u ldg16(const void* sbase, unsigned voff) { return __builtin_nontemporal_load((const v4u*)((const char*)sbase + voff)); }
constexpr int R1_LV = 0, R1_LKF = 32768, R1_LKB = 49152;
__device__ __forceinline__ void ret_kv_phase(const Ptrs& P, LAS unsigned char* lds, int vcu, int G) {
    const int tid = threadIdx.x, lane = tid & 63, r32 = lane & 31, hi = lane >> 5, wid = __builtin_amdgcn_readfirstlane(tid >> 6), dir = wid & 1, dvb = wid >> 1;
    const int trbase = ((lane >> 4) & 1) * 32 + (lane & 3) * 8 + (4 * hi + ((lane & 15) >> 2)) * 64;
    constexpr int NU = NB * RH * NC;
    const unsigned vrow0 = (unsigned)tid >> 4, vpc = (unsigned)tid & 15, krow0 = (unsigned)tid >> 3, kpc = (unsigned)tid & 7;
    const unsigned vo_v = vrow0 * (RW * 2) + vpc * 16, vo_k = krow0 * (RQW * 2) + kpc * 16;
    v4u vv[4], krv[2]; float dsf[2], dsb[2];
#define R1_LOAD(uu) do { const int c_ = (uu) & 127, h_ = ((uu) >> 7) & 7, b_ = (uu) >> 10; const size_t t0_ = (size_t)b_ * SEQ + c_ * CH; \
        _Pragma("unroll") for (int i = 0; i < 4; ++i) vv[i] = ldg16(P.vr + (t0_ + 32 * i) * RW + h_ * RDV, vo_v); \
        _Pragma("unroll") for (int i = 0; i < 2; ++i) { krv[i] = ldg16(P.kf + (t0_ + 64 * i) * RQW + h_ * RDK, vo_k); dsf[i] = P.decT[2 * 1024 + h_ * 128 + krow0 + 64 * i]; dsb[i] = P.decT[3 * 1024 + h_ * 128 + krow0 + 64 * i]; } } while (0)
    if (vcu < NU) R1_LOAD(vcu);
    for (int u = vcu; u < NU; u += G) {
        const int c = u & 127, h = (u >> 7) & 7, b = u >> 10;
        LDS_BAR();
#pragma unroll
        for (int i = 0; i < 4; ++i) { const int row = vrow0 + 32 * i; *(LAS v4u*)(lds + R1_LV + ((vpc >> 2) * 8 + (row >> 4)) * 1024 + (row & 15) * 64 + (vpc & 3) * 16) = vv[i]; }
#pragma unroll
        for (int i = 0; i < 2; ++i) { const int row = krow0 + 64 * i, off = ((kpc >> 2) * 8 + (row >> 4)) * 1024 + (row & 15) * 64 + (kpc & 3) * 16;
            *(LAS v4u*)(lds + R1_LKF + off) = scale8(krv[i], dsf[i]); *(LAS v4u*)(lds + R1_LKB + off) = scale8(krv[i], dsb[i]); }
        LDS_BAR();
        if (u + G < NU) R1_LOAD(u + G);
        f32x16 a0 = {}, a1 = {};
        const lds_cptr vb = (lds_cptr)(lds + R1_LV + dvb * 8192) + trbase, kb_ = (lds_cptr)(lds + (dir ? R1_LKB : R1_LKF)) + trbase;
#pragma unroll
        for (int ks = 0; ks < 8; ++ks) { const bf16x8 av = vtr8(vb + ks * 1024), b0 = vtr8(kb_ + ks * 1024), b1 = vtr8(kb_ + 8192 + ks * 1024);
            a0 = MFMA32(av, b0, a0); a1 = MFMA32(av, b1, a1); }
        LAS bf16* stg = (LAS bf16*)(lds + 65536) + wid * 2048;
#pragma unroll
        for (int r = 0; r < 16; ++r) { const int orow = crow(r, hi); stg[orow * 64 + r32] = (bf16)f2bf(a0[r]); stg[orow * 64 + 32 + r32] = (bf16)f2bf(a1[r]); }
        asm volatile("s_waitcnt lgkmcnt(0)" ::: "memory");
        bf16* gp = P.G + ((((size_t)(b * RH + h) * NC + c) * 2 + dir) * 8192) + dvb * 32 * 64;
#pragma unroll
        for (int i = 0; i < 4; ++i) *(v4u*)(gp + (i * 64 + lane) * 8) = *(const LAS v4u*)(stg + (i * 64 + lane) * 8);
    }
#undef R1_LOAD
}
constexpr int R3_CS = 2064, R3_TB = 8 * R3_CS;
constexpr int R3_KF = 0, R3_KB = R3_TB, R3_QF = 2 * R3_TB, R3_QB = 3 * R3_TB, R3_SF = 4 * R3_TB, R3_SB = 5 * R3_TB, R3_V = 6 * R3_TB, R3_GW = R3_V + 32768, R3_XCH = R3_GW + 512, R3_END = R3_XCH + 2048;
static_assert(R3_END <= LDSCTL_OFF && 8 * 4096 <= 2 * R3_TB, "R3 LDS map");
__device__ __forceinline__ void attn_ra(const Ptrs& P, int gt, int NGT);
template <int MODE> __device__ __forceinline__ void ret_out_phase(const Ptrs& P, LAS unsigned char* lds, int vcu, int G, int gt = 0, int NGT = 0) {
    const int tid = threadIdx.x, lane = tid & 63, r32 = lane & 31, hi = lane >> 5, wid = __builtin_amdgcn_readfirstlane(tid >> 6), qi = wid & 3, dvh = wid >> 2;
    const int trbase = ((lane >> 4) & 1) * 32 + (lane & 3) * 8 + (4 * hi + ((lane & 15) >> 2)) * 64;
    constexpr int NU = NB * RH * NC;
    const unsigned row0 = (unsigned)tid >> 3, chn = (unsigned)tid & 7;
    const unsigned vo_k = row0 * (RQW * 2) + chn * 16, vo_s = row0 * 128 + chn * 16, vo_v = (unsigned)(lane >> 4) * (RW * 2) + (unsigned)(lane & 15) * 16;
    const unsigned lo_k = chn * R3_CS + row0 * 16;
    v4u krv[2], qrv[2], sfv[2], sbv[2], vv[4]; f32x4 gwv = {0.f, 0.f, 0.f, 0.f}; float dsc[2][4];
#define R3_LOAD(uu) do { const int c_ = (uu) & 127, h_ = ((uu) >> 7) & 7, b_ = (uu) >> 10; const size_t t0_ = (size_t)b_ * SEQ + c_ * CH; \
        const size_t ko = t0_ * RQW + h_ * RDK; const bf16* sb_ = P.st + ((((size_t)(b_ * RH + h_) * NC + c_) * 2) * 8192); \
        _Pragma("unroll") for (int j = 0; j < 2; ++j) { \
            krv[j] = ldg16(P.kf + ko + j * 64 * RQW, vo_k); qrv[j] = ldg16(P.qf + ko + j * 64 * RQW, vo_k); \
            _Pragma("unroll") for (int kd = 0; kd < 4; ++kd) dsc[j][kd] = P.decT[kd * 1024 + h_ * 128 + row0 + 64 * j]; \
            sfv[j] = *(const v4u*)((const char*)(sb_ + j * 64 * 64) + vo_s); sbv[j] = *(const v4u*)((const char*)(sb_ + 8192 + j * 64 * 64) + vo_s); } \
        _Pragma("unroll") for (int i = 0; i < 4; ++i) vv[i] = ldg16(P.vr + (t0_ + (wid * 4 + i) * 4) * RW + h_ * RDV, vo_v); \
        if (tid < 32) gwv = *(const f32x4*)(P.gn_w + h_ * RDV + tid * 4); } while (0)
    if (vcu < NU) R3_LOAD(vcu);
    if (NGT > 0) attn_ra(P, gt, NGT);
    for (int u = vcu; u < NU; u += G) {
        const int c = u & 127, h = (u >> 7) & 7, b = u >> 10; const size_t t0 = (size_t)b * SEQ + c * CH;
        LDS_BAR();
#pragma unroll
        for (int j = 0; j < 2; ++j) { LAS unsigned char* d = lds + lo_k + j * 1024;
            *(LAS v4u*)(d + R3_QF) = scale8(qrv[j], dsc[j][0]); *(LAS v4u*)(d + R3_QB) = scale8(qrv[j], dsc[j][1]); *(LAS v4u*)(d + R3_KF) = scale8(krv[j], dsc[j][2]); *(LAS v4u*)(d + R3_KB) = scale8(krv[j], dsc[j][3]);
            *(LAS v4u*)(d + R3_SF) = sfv[j]; *(LAS v4u*)(d + R3_SB) = sbv[j]; }
#pragma unroll
        for (int i = 0; i < 4; ++i) { const int row = (wid * 4 + i) * 4 + (lane >> 4);
            *(LAS v4u*)(lds + R3_V + ((((lane & 15) >> 2) * 8 + (row >> 4)) * 1024) + (row & 15) * 64 + (lane & 3) * 16) = vv[i]; }
        if (tid < 32) ((LAS f32x4*)(lds + R3_GW))[tid] = gwv;
        LDS_BAR();
        const size_t tokb = t0 + qi * 32; const int colb = h * RDV + dvh * 64;
        v4u gv[4];
#pragma unroll
        for (int i = 0; i < 4; ++i) gv[i] = __builtin_nontemporal_load((const v4u*)(P.gr + (tokb + i * 8 + (lane >> 3)) * RW + colb + (lane & 7) * 8));
        if (u + G < NU) R3_LOAD(u + G);
        __builtin_amdgcn_sched_barrier(0);
        if (MODE == 2) { asm volatile("" :: "v"(gv[0]), "v"(gv[1]), "v"(gv[2]), "v"(gv[3])); continue; }
        const lds_cptr fb = (lds_cptr)lds + hi * R3_CS + r32 * 16;
        bf16x8 qff[4], qbf[4];
#pragma unroll
        for (int d0 = 0; d0 < 4; ++d0) { qff[d0] = *(const LAS bf16x8*)(fb + R3_QF + d0 * 2 * R3_CS + qi * 512); qbf[d0] = *(const LAS bf16x8*)(fb + R3_QB + d0 * 2 * R3_CS + qi * 512); }
        f32x16 o[2];
        o[0] = (f32x16){}; o[1] = (f32x16){};
#pragma unroll
        for (int dp = 0; dp < 2; ++dp) {
            bf16x8 sr[8];
#pragma unroll
            for (int dd = 0; dd < 2; ++dd)
#pragma unroll
                for (int dbl = 0; dbl < 2; ++dbl) { const int ro = (dvh * 2 + dbl) * 512 + (dp * 2 + dd) * 2 * R3_CS;
                    sr[dd * 4 + dbl * 2] = *(const LAS bf16x8*)(fb + R3_SF + ro); sr[dd * 4 + dbl * 2 + 1] = *(const LAS bf16x8*)(fb + R3_SB + ro); }
            __builtin_amdgcn_sched_barrier(0);
#pragma unroll
            for (int dd = 0; dd < 2; ++dd) { const int d0 = dp * 2 + dd;
                o[0] = MFMA32(sr[dd * 4 + 0], qff[d0], o[0]); o[1] = MFMA32(sr[dd * 4 + 2], qff[d0], o[1]);
                o[0] = MFMA32(sr[dd * 4 + 1], qbf[d0], o[0]); o[1] = MFMA32(sr[dd * 4 + 3], qbf[d0], o[1]); }
            __builtin_amdgcn_sched_barrier(0);
        }
        const lds_cptr vb = (lds_cptr)(lds + R3_V) + trbase;
#pragma unroll
        for (int kj = 0; kj < 4; ++kj) {
            f32x16 sf = {}, sbw = {};
            if (kj <= qi) {
                bf16x8 kr_[4];
#pragma unroll
                for (int d0 = 0; d0 < 4; ++d0) kr_[d0] = *(const LAS bf16x8*)(fb + R3_KF + d0 * 2 * R3_CS + kj * 512);
                __builtin_amdgcn_sched_barrier(0);
#pragma unroll
                for (int d0 = 0; d0 < 4; ++d0) sf = MFMA32(kr_[d0], qff[d0], sf);
            }
            if (kj >= qi) {
                bf16x8 kr_[4];
#pragma unroll
                for (int d0 = 0; d0 < 4; ++d0) kr_[d0] = *(const LAS bf16x8*)(fb + R3_KB + d0 * 2 * R3_CS + kj * 512);
                __builtin_amdgcn_sched_barrier(0);
#pragma unroll
                for (int d0 = 0; d0 < 4; ++d0) sbw = MFMA32(kr_[d0], qbf[d0], sbw);
            }
            f32x16 p;
#pragma unroll
            for (int r = 0; r < 16; ++r) p[r] = (kj < qi) ? sf[r] : (kj > qi) ? sbw[r] : ((crow(r, hi) <= r32) ? sf[r] : sbw[r]);
            const bf16x8 pw0 = PK8(p, 0), pw1 = PK8(p, 8);
            bf16x8 vf_[4];
#pragma unroll
            for (int dbl = 0; dbl < 2; ++dbl) { const int db = dvh * 2 + dbl; vf_[dbl * 2] = vtr8(vb + (db * 8 + kj * 2) * 1024); vf_[dbl * 2 + 1] = vtr8(vb + (db * 8 + kj * 2 + 1) * 1024); }
            __builtin_amdgcn_sched_barrier(0);
            o[0] = MFMA32(vf_[0], pw0, o[0]); o[1] = MFMA32(vf_[2], pw0, o[1]); o[0] = MFMA32(vf_[1], pw1, o[0]); o[1] = MFMA32(vf_[3], pw1, o[1]);
        }
        float s1 = 0.f, s2 = 0.f;
#pragma unroll
        for (int dbl = 0; dbl < 2; ++dbl)
#pragma unroll
            for (int r = 0; r < 16; ++r) { s1 += o[dbl][r]; s2 += o[dbl][r] * o[dbl][r]; }
        s1 = half_swap_sum(s1); s2 = half_swap_sum(s2);
        if (MODE == 1) { asm volatile("" :: "v"(s1), "v"(s2), "v"(gv[0]), "v"(gv[1]), "v"(gv[2]), "v"(gv[3])); LDS_BAR(); continue; }
        typedef float f32x2_t __attribute__((ext_vector_type(2)));
        LAS f32x2_t* xch = (LAS f32x2_t*)(lds + R3_XCH);
        if (hi == 0) xch[wid * 32 + r32] = (f32x2_t){s1, s2};
        LDS_BAR();
        { const f32x2_t pp = xch[(wid ^ 4) * 32 + r32]; s1 += pp.x; s2 += pp.y; }
        const float mu = s1 * (1.0f / RDV), var = fmaxf(s2 * (1.0f / RDV) - mu * mu, 0.f), rs = 1.0f / sqrtf(var + EPS);
        const LAS f32x4* gw = (const LAS f32x4*)(lds + R3_GW);
        LAS unsigned char* stg = lds + wid * 4096;
#pragma unroll
        for (int dbl = 0; dbl < 2; ++dbl)
#pragma unroll
            for (int rq = 0; rq < 4; ++rq) { const int cl = dbl * 32 + 8 * rq + 4 * hi; const f32x4 w = gw[(dvh * 64 + cl) >> 2];
                u32x2 ov; ov.x = cvtpk((o[dbl][4 * rq] - mu) * rs * w.x, (o[dbl][4 * rq + 1] - mu) * rs * w.y); ov.y = cvtpk((o[dbl][4 * rq + 2] - mu) * rs * w.z, (o[dbl][4 * rq + 3] - mu) * rs * w.w);
                *(LAS u32x2*)(stg + r32 * 128 + cl * 2) = ov; }
        asm volatile("s_waitcnt lgkmcnt(0)" ::: "memory");
        v4u sv[4];
#pragma unroll
        for (int i = 0; i < 4; ++i) { const int tk = i * 8 + (lane >> 3); sv[i] = *(const LAS v4u*)(stg + tk * 128 + (lane & 7) * 16); }
#pragma unroll
        for (int i = 0; i < 4; ++i) { const int tk = i * 8 + (lane >> 3); float a[8], g8[8], y[8]; unpack8(sv[i], a); unpack8(gv[i], g8);
#pragma unroll
            for (int k = 0; k < 8; ++k) y[k] = a[k] * g8[k];
            const v4u yv = pack8(y); if (MODE == 3) asm volatile("" :: "v"(yv)); else *(v4u*)(P.mix + (tokb + tk) * DM + AW + colb + (lane & 7) * 8) = yv; }
    }
#undef R3_LOAD
}
__device__ __forceinline__ void attn_ra(const Ptrs& P, int gt, int NGT) {
    for (int t = gt; t < T; t += NGT) { const f32x4* sp = (const f32x4*)(P.ssq + (size_t)t * 16); const f32x4 a = sp[0], b = sp[1], c = sp[2], d = sp[3];
        const float ss = ((a.x + a.y) + (a.z + a.w)) + ((b.x + b.y) + (b.z + b.w)) + ((c.x + c.y) + (c.z + c.w)) + ((d.x + d.y) + (d.z + d.w));
        P.ra[t] = 1.0f / sqrtf(ss * (1.0f / AW) + EPS); }
}
__device__ __forceinline__ void ret_scan(const Ptrs& P, int gt, int NGT) {
    for (int q = gt; q < NB * RH * 2 * 4096; q += NGT) {
        const int e2 = q & 4095, dir = (q >> 12) & 1, h = (q >> 13) & 7, b = q >> 16;
        const float gam = P.gam[dir * 8 + h];
        float S0 = 0.f, S1 = 0.f;
        const size_t base = (((size_t)(b * RH + h) * NC) * 2 + dir) * 8192 + e2 * 2;
        for (int c0 = 0; c0 < NC; c0 += 32) {
            unsigned g[32];
#pragma unroll
            for (int k = 0; k < 32; ++k) { const int c = dir ? (NC - 1 - (c0 + k)) : (c0 + k); g[k] = *(const unsigned*)(P.G + base + (size_t)c * 16384); }
#pragma unroll
            for (int k = 0; k < 32; ++k) { const int c = dir ? (NC - 1 - (c0 + k)) : (c0 + k);
                *(unsigned*)(P.st + base + (size_t)c * 16384) = pk2(S0, S1);
                S0 = (S0 + bflo(g[k])) * gam; S1 = (S1 + bfhi(g[k])) * gam; }
        }
    }
}
__device__ __forceinline__ void final_norm2(const Ptrs& P, int gw, int NGW, int lane, int r0, int nrows) {
    f32x4 wv[8];
    { const GAS f32x4* wr_ = (const GAS f32x4*)P.fin_w + lane;
#pragma unroll
      for (int j = 0; j < 8; ++j) wv[j] = wr_[64 * j]; }
    for (int mr = gw; mr < nrows; mr += 2 * NGW) {
        const int m = r0 + mr, m2 = m + NGW; const bool has2 = mr + NGW < nrows; const int mb = has2 ? m2 : m;
        const GAS f32x4* xa = (const GAS f32x4*)(P.x + (size_t)m * DM) + lane; const GAS f32x4* xb = (const GAS f32x4*)(P.x + (size_t)mb * DM) + lane;
        const GAS u32x2* da = (const GAS u32x2*)(P.dlt + (size_t)m * DM) + lane; const GAS u32x2* db = (const GAS u32x2*)(P.dlt + (size_t)mb * DM) + lane;
        f32x4 va[8], vb[8]; u32x2 ea[8], eb[8];
#pragma unroll
        for (int j = 0; j < 8; ++j) { va[j] = __builtin_nontemporal_load(xa + 64 * j); vb[j] = __builtin_nontemporal_load(xb + 64 * j); ea[j] = da[64 * j]; eb[j] = db[64 * j]; }
        float sa_ = 0.f, sb_ = 0.f;
#pragma unroll
        for (int j = 0; j < 8; ++j) {
            va[j].x += bflo(ea[j].x); va[j].y += bfhi(ea[j].x); va[j].z += bflo(ea[j].y); va[j].w += bfhi(ea[j].y);
            vb[j].x += bflo(eb[j].x); vb[j].y += bfhi(eb[j].x); vb[j].z += bflo(eb[j].y); vb[j].w += bfhi(eb[j].y);
            sa_ += (va[j].x * va[j].x + va[j].y * va[j].y) + (va[j].z * va[j].z + va[j].w * va[j].w); sb_ += (vb[j].x * vb[j].x + vb[j].y * vb[j].y) + (vb[j].z * vb[j].z + vb[j].w * vb[j].w); }
        const float ra_ = 1.0f / sqrtf(wave_sum(sa_) * (1.f / DM) + EPS), rb_ = 1.0f / sqrtf(wave_sum(sb_) * (1.f / DM) + EPS);
        GAS f32x4* oa = (GAS f32x4*)(P.out + (size_t)m * DM) + lane; GAS f32x4* ob = (GAS f32x4*)(P.out + (size_t)m2 * DM) + lane;
#pragma unroll
        for (int j = 0; j < 8; ++j) { const f32x4 w = wv[j]; f32x4 o; o.x = va[j].x * ra_ * w.x; o.y = va[j].y * ra_ * w.y; o.z = va[j].z * ra_ * w.z; o.w = va[j].w * ra_ * w.w; st16_aux(P.out + (size_t)m * DM, (unsigned)(lane * 16 + j * 1024), __builtin_bit_cast(v4u, o));
            if (has2) { f32x4 o2; o2.x = vb[j].x * rb_ * w.x; o2.y = vb[j].y * rb_ * w.y; o2.z = vb[j].z * rb_ * w.z; o2.w = vb[j].w * rb_ * w.w; st16_aux(P.out + (size_t)m2 * DM, (unsigned)(lane * 16 + j * 1024), __builtin_bit_cast(v4u, o2)); } }
    }
}

#ifndef STAGGER_TICKS
#define STAGGER_TICKS 250
#endif
#ifndef MK_N_LAUNCHES
#define MK_N_LAUNCHES 1
#endif
constexpr int N_PHASES = 7;
struct Args { const float* in[11]; float* out; unsigned char* ws; int ph_lo, ph_hi; };
__device__ __forceinline__ void make_ptrs(Ptrs& P, const Args& args) {
    unsigned char* ws = args.ws;
    P.x = args.in[0]; P.norm_w = args.in[1]; P.w_in = args.in[2]; P.sink = args.in[3]; P.rel_bias = args.in[4]; P.aon_w = args.in[5];
    P.dec_f = args.in[6]; P.dec_b = args.in[7]; P.gn_w = args.in[8]; P.w_out = args.in[9]; P.fin_w = args.in[10]; P.out = args.out;
    P.win_t = (bf16*)(ws + WS_WIN); P.wo_t = (bf16*)(ws + WS_WO); P.xn = (bf16*)(ws + WS_XN); P.mix = (bf16*)(ws + WS_MIX);
    P.qa = (bf16*)(ws + WS_QA); P.ka = (bf16*)(ws + WS_KA); P.va = (bf16*)(ws + WS_VA); P.ga = (bf16*)(ws + WS_GA);
    P.qf = (bf16*)(ws + WS_QF); P.qb = (bf16*)(ws + WS_QB); P.kf = (bf16*)(ws + WS_KF); P.kb = (bf16*)(ws + WS_KB);
    P.vr = (bf16*)(ws + WS_VR); P.gr = (bf16*)(ws + WS_GR); P.st = (bf16*)(ws + WS_ST); P.dlt = (bf16*)(ws + WS_DLT);
    P.cosT = (float*)(ws + WS_COS); P.sinT = (float*)(ws + WS_SIN); P.decT = (float*)(ws + WS_DEC); P.biasT = (float*)(ws + WS_BIAS);
    P.sink2 = (float*)(ws + WS_SINK); P.gam = (float*)(ws + WS_GAM); P.ssq = (float*)(ws + WS_SSQ); P.ra = (float*)(ws + WS_SSQ + 2 * MiB); P.G = (bf16*)(ws + WS_G);

}
__global__ void __launch_bounds__(NWAVES * 64, 2) hymba_fwd(Args args) {
    extern __shared__ __attribute__((aligned(16))) unsigned char lds_raw[];
    LAS unsigned char* lds = (LAS unsigned char*)lds_raw;
    volatile LAS unsigned* MISC = (volatile LAS unsigned*)(lds + MISC_OFF);
    const int tid = threadIdx.x, lane = tid & 63, wave = __builtin_amdgcn_readfirstlane(tid >> 6);
    const int G = gridDim.x, bx = blockIdx.x, vcu = (G % 8 == 0) ? (bx % 8) * (G / 8) + bx / 8 : bx;
    const int gw = vcu * NWAVES + wave, NGW = G * NWAVES, gt = gw * 64 + lane, NGT = NGW * 64;
    unsigned char* ws = args.ws;
    gu32* ctl = (gu32*)(ws + WS_CTL);
    for (int u = tid; u < (LDS_BYTES - LDSCTL_OFF) / 4; u += NWAVES * 64) ((LAS unsigned*)(lds + LDSCTL_OFF))[u] = 0u;
    __syncthreads();
    XcdBarrier bar; bar.bar = (unsigned*)(ctl + CW_BAR); bar.x = 0; bar.st = nullptr;
    if (MK_N_LAUNCHES == 1) bar = xcd_barrier_post((unsigned*)(ctl + CW_BAR), MISC + 8);
    const int lo = args.ph_lo, hi = args.ph_hi;
#ifndef TEST_PHASES
#define TEST_PHASES 127
#endif
#define IN(k) (((TEST_PHASES >> (k)) & 1) && lo <= (k) && (k) < hi)
#define SEAM(k) do { if (IN(k) && IN((k) + 1)) xcd_barrier(bar); } while (0)
#ifndef REPEAT_MASK
#define REPEAT_MASK 0
#endif
#define NREP(k) (((REPEAT_MASK >> (k)) & 1) ? 2 : 1)

    if (IN(0)) { Ptrs P; make_ptrs(P, args); for (int rep_ = 0; rep_ < NREP(0); ++rep_) p0_prologue(P, lds, gw, NGW, wave, lane); SEAM(0); }
    if (IN(1)) for (int rep_ = 0; rep_ < NREP(1); ++rep_) { Ptrs P; make_ptrs(P, args);
        pg8::Gemm g{P.xn, P.win_t, T, INW, DM}; pg8::StaticOrder S; S.init(T, INW, G, bx);
        EpiIn E{P.qa, P.ka, P.va, P.ga, P.qf, P.qb, P.kf, P.kb, P.vr, P.gr, P.cosT, P.sinT, P.decT};
        pg8::gemm_phase<EpiIn, pg8::StaticOrder, false, true>(lds + RING_OFF, g, S, E);
        if (rep_ == NREP(1) - 1) SEAM(1);
    }
    if (IN(2)) { Ptrs P; make_ptrs(P, args); for (int rep_ = 0; rep_ < NREP(8); ++rep_) ret_kv_phase(P, lds, vcu, G); SEAM(2); }
    if (IN(3)) { Ptrs P; make_ptrs(P, args); attn_phase(P, lds, vcu, G, gt, NGT); SEAM(3); }
    if (IN(4)) { Ptrs P; make_ptrs(P, args); ret_out_phase<0>(P, lds, vcu, G, gt, NGT); if (NREP(4) > 1) ret_out_phase<0>(P, lds, vcu, G); if (NREP(11) > 1) ret_out_phase<1>(P, lds, vcu, G); if (NREP(12) > 1) ret_out_phase<2>(P, lds, vcu, G); if (NREP(13) > 1) ret_out_phase<3>(P, lds, vcu, G); SEAM(4); }
    if (IN(5)) { Ptrs P; make_ptrs(P, args);
        const bool grpA = (vcu & 1) == 0; const int nA = (G + 1) / 2, nB = G / 2, grank = vcu >> 1;
        const int gwl = grank * NWAVES + wave, ngwl = (grpA ? nA : nB) * NWAVES;
        const int rowsA = (G > 1) ? SEQ / 2 : SEQ;
        { pg8::Gemm g{P.mix, P.wo_t, SEQ, DM, DM}; pg8::StaticOrder S; S.init(SEQ, DM, G, bx); EpiDelta E{P.dlt, P.ra};
          pg8::gemm_phase<EpiDelta, pg8::StaticOrder, true, true>(lds + RING_OFF, g, S, E); }
        if (MK_N_LAUNCHES == 1) xcd_barrier(bar);
        if (grpA) final_norm2(P, gwl, ngwl, lane, 0, rowsA);
        { pg8::Gemm g{P.mix + (size_t)SEQ * DM, P.wo_t, SEQ, DM, DM}; pg8::StaticOrder S; S.init(SEQ, DM, G, bx); EpiDelta E{P.dlt + (size_t)SEQ * DM, P.ra + SEQ};
          pg8::gemm_phase<EpiDelta, pg8::StaticOrder, true, true>(lds + RING_OFF, g, S, E); }
        if (!grpA) final_norm2(P, gwl, ngwl, lane, rowsA, SEQ - rowsA);
        SEAM(5);
    }
    if (IN(6)) { Ptrs P; make_ptrs(P, args); final_norm2(P, gw, NGW, lane, SEQ, SEQ); }
#undef IN
#undef SEAM
}

extern "C" void kernel_launch(void* const* d_in, const int* in_sizes, int n_in, void* d_out, int out_size, void* d_ws, size_t ws_size, hipStream_t stream) {
    static int grid = 0;
    if (grid == 0) {
        if (n_in != 11 || in_sizes[0] != T * DM || out_size != T * DM || ws_size < WS_END) {
            fprintf(stderr, "kernel_launch: unexpected shapes: n_in %d in0 %d out %d ws %zu (need %zu)\n", n_in, n_in > 0 ? in_sizes[0] : -1, out_size, ws_size, (size_t)WS_END); grid = -1; return; }
        int dev = 0, cus = 0;
        if (hipGetDevice(&dev) != hipSuccess || hipDeviceGetAttribute(&cus, hipDeviceAttributeMultiprocessorCount, dev) != hipSuccess) { grid = -1; return; }
        if (hipFuncSetAttribute((const void*)hymba_fwd, hipFuncAttributeMaxDynamicSharedMemorySize, LDS_BYTES) != hipSuccess) { fprintf(stderr, "kernel_launch: hipFuncSetAttribute failed\n"); grid = -1; return; }
        int per_cu = 0;
        if (hipOccupancyMaxActiveBlocksPerMultiprocessor(&per_cu, (const void*)hymba_fwd, NWAVES * 64, LDS_BYTES) != hipSuccess || per_cu < 1)
            fprintf(stderr, "kernel_launch: occupancy query reports %d blocks per CU\n", per_cu);
        (void)hipGetLastError();
        grid = cus;
    }
    if (grid < 0) return;
    (void)hipMemsetAsync((char*)d_ws + WS_CTL, 0, CTL_ZERO_BYTES, stream);
    Args a{};
    for (int i = 0; i < 11; ++i) a.in[i] = (const float*)d_in[i];
    a.out = (float*)d_out; a.ws = (unsigned char*)d_ws;
    if (MK_N_LAUNCHES == 1) { a.ph_lo = 0; a.ph_hi = N_PHASES; hipLaunchKernelGGL(hymba_fwd, dim3(grid), dim3(NWAVES * 64), LDS_BYTES, stream, a); }
    else for (int li = 0; li < N_PHASES; ++li) { a.ph_lo = li; a.ph_hi = li + 1; hipLaunchKernelGGL(hymba_fwd, dim3(grid), dim3(NWAVES * 64), LDS_BYTES, stream, a); }
}
```

```cpp
#include <hip/hip_runtime.h>
#include <cstdio>
#include <cstdint>
namespace pg8 {
#define PG8_LAS __attribute__((address_space(3)))
typedef unsigned short bf16_t;
typedef short bf16x8 __attribute__((ext_vector_type(8)));
typedef float f32x4 __attribute__((ext_vector_type(4)));
typedef unsigned u32x4 __attribute__((ext_vector_type(4)));
constexpr int BM = 256, BK = 64, HALF = 128, HTB = HALF * BK * 2  , STAGE_BYTES = 8 * HTB, NXCD = 8, WGM = 8;

__host__ __device__ __forceinline__ int lds_byte(int r, int c) { const int st = (r >> 4) * 2 + (c >> 5), rr = r & 15, cc = c & 31, ob = rr * 64 + cc * 2; return st * 1024 + (ob ^ (((ob >> 9) & 1) << 5)); }
__host__ __device__ __forceinline__ void stage_rc(int b, int& R, int& C) { const int st = b / 1024, sb = b % 1024, swz = sb ^ (((sb >> 9) & 1) << 5); R = (st >> 1) * 16 + swz / 64; C = (st & 1) * 32 + (swz % 64) / 2; }
__host__ __device__ __forceinline__ int perm32(int rho) { const int n = rho >> 4, i = rho & 15; return 8 * (i >> 2) + 4 * n + (i & 3); }

struct Unit { int pm, pn; };
struct Gemm { const bf16_t* A; const bf16_t* Bt; int M, N, K; };

struct StaticOrder {
    int nM, nN, nwg, G, c;
    __host__ __device__ void init(int M, int N, int G_, int c_) { nM = M / BM; nN = N / BM; nwg = nM * nN; G = G_; c = c_; }
    __host__ __device__ bool next(int i, Unit& u) const {
        const long L = (long)i * G + c; if (L >= nwg) return false;
        int wgid = (int)L; { const int q = nwg / NXCD, r = nwg % NXCD, xcd = wgid % NXCD, off = wgid / NXCD; wgid = (xcd < r ? xcd * (q + 1) : r * (q + 1) + (xcd - r) * q) + off; }
        const int nig = WGM * nN, gid = wgid / nig, fm = gid * WGM, gsz = (nM - fm) < WGM ? (nM - fm) : WGM;
        u.pm = fm + ((wgid % nig) % gsz); u.pn = (wgid % nig) / gsz; return true;
    }
    __device__ __forceinline__ void a_ready(const Unit&) const {}
    __device__ __forceinline__ void done(const Unit&) const {}
};

__device__ __forceinline__ unsigned cvt_pk_bf16(float lo, float hi) { unsigned r; asm volatile("v_cvt_pk_bf16_f32 %0, %1, %2" : "=v"(r) : "v"(lo), "v"(hi)); return r; }
typedef float f32x2 __attribute__((ext_vector_type(2)));
template <class Epi, class Sched, bool ALIGN_EPI = false, bool SP2 = false>
__device__ __forceinline__ void gemm_phase(PG8_LAS unsigned char* lds, const Gemm g, const Sched& S, const Epi& E) {
    const int tid = threadIdx.x, wid = __builtin_amdgcn_readfirstlane(tid >> 6), lane = tid & 63, wr = wid >> 2, wc = wid & 3, fr = lane & 15, fq = lane >> 4;
    const int K = g.K, nt = K / BK;
    unsigned voffA[2], voffB[2];
#pragma unroll
    for (int i = 0; i < 2; ++i) { int R, C; stage_rc(tid * 16 + i * 8192, R, C); const int Rb = Epi::PERM ? ((R & ~31) + perm32(R & 31)) : R;
        voffA[i] = (unsigned)(R * K + C) * 2u; voffB[i] = (unsigned)(Rb * K + C) * 2u; }
    const size_t kstep = (size_t)(BK * 2);
    const size_t hstep = (size_t)HALF * K * 2;
    const size_t tstep = 2 * hstep;
    const unsigned ldsw = (unsigned)wid * 1024u;
    const int aoff = lds_byte(wr * 64 + fr, fq * 8), boff = lds_byte(wc * 32 + fr, fq * 8);
#define PG8_SA(b, h) (((b) * 2 + (h)) * HTB)
#define PG8_SB(b, h) ((4 + (b) * 2 + (h)) * HTB)
#define PG8_STAGE(bufoff, gbase, voff) do { _Pragma("unroll") for (int _i = 0; _i < 2; ++_i) \
        __builtin_amdgcn_global_load_lds((const unsigned*)((const char*)(gbase) + (voff)[_i]), (PG8_LAS unsigned*)(lds + (bufoff) + ldsw + _i * 8192), 16, 0, 0); } while (0)
#define PG8_LDA(dst, b, h) do { _Pragma("unroll") for (int m = 0; m < 4; ++m) _Pragma("unroll") for (int k = 0; k < 2; ++k) dst[m][k] = *(const PG8_LAS bf16x8*)(lds + PG8_SA(b, h) + aoff + m * 2048 + k * 1024); } while (0)
#define PG8_LDB(dst, b, h) do { _Pragma("unroll") for (int n = 0; n < 2; ++n) _Pragma("unroll") for (int k = 0; k < 2; ++k) dst[n][k] = *(const PG8_LAS bf16x8*)(lds + PG8_SB(b, h) + boff + n * 2048 + k * 1024); } while (0)
#define PG8_MMA(ai, bj, At, Bt) do { __builtin_amdgcn_s_setprio(1); _Pragma("unroll") for (int m = 0; m < 4; ++m) _Pragma("unroll") for (int n = 0; n < 2; ++n) _Pragma("unroll") for (int k = 0; k < 2; ++k) \
        acc[ai][bj][m][n] = __builtin_amdgcn_mfma_f32_16x16x32_bf16(Bt[n][k], At[m][k], acc[ai][bj][m][n], 0, 0, 0); __builtin_amdgcn_s_setprio(0); } while (0)
#define PG8_WAIT_V(n) asm volatile("s_waitcnt vmcnt(" #n ")" ::: "memory")
#define PG8_WAIT_V_SEL(f) asm volatile("v_readfirstlane_b32 s100, %0\n\ts_nop 4\n\ts_cmp_lg_u32 s100, 0\n\ts_cbranch_scc0 .Lpgw%=a\n\ts_waitcnt vmcnt(24)\n\ts_branch .Lpgw%=b\n.Lpgw%=a:\n\ts_waitcnt vmcnt(8)\n.Lpgw%=b:" :: "v"(f) : "memory", "scc", "s100")
#define PG8_WAIT_L(n) asm volatile("s_waitcnt lgkmcnt(" #n ")" ::: "memory")
#define PG8_BAR __builtin_amdgcn_s_barrier()
#define PG8_SCHED __builtin_amdgcn_sched_barrier(0)
    Unit cur, nxt; int ui = 0;
    if (!S.next(0, cur)) return;
    f32x4 acc[2][2][4][2];
#pragma unroll
    for (int a = 0; a < 2; ++a)
#pragma unroll
        for (int b = 0; b < 2; ++b)
#pragma unroll
            for (int m = 0; m < 4; ++m)
#pragma unroll
                for (int n = 0; n < 2; ++n) acc[a][b][m][n] = (f32x4){0.f, 0.f, 0.f, 0.f};
    bf16x8 At[4][2], B0[2][2], B1[2][2];
    const char* cA = (const char*)g.A + (size_t)cur.pm * tstep; const char* cB = (const char*)g.Bt + (size_t)cur.pn * tstep;
    S.a_ready(cur);
    if constexpr (SP2) {
        PG8_STAGE(PG8_SB(0, 0), cB, voffB); PG8_STAGE(PG8_SB(0, 1), cB + hstep, voffB); PG8_STAGE(PG8_SA(0, 0), cA, voffA); PG8_STAGE(PG8_SA(0, 1), cA + hstep, voffA);
        if (wr == 1) PG8_BAR;
        PG8_WAIT_V(2); PG8_BAR;
        PG8_STAGE(PG8_SB(1, 0), cB + kstep, voffB); PG8_STAGE(PG8_SA(1, 0), cA + kstep, voffA); PG8_STAGE(PG8_SB(1, 1), cB + hstep + kstep, voffB);
        PG8_WAIT_V(6); PG8_BAR;
    } else {
        PG8_STAGE(PG8_SB(0, 0), cB, voffB); PG8_STAGE(PG8_SA(0, 0), cA, voffA); PG8_STAGE(PG8_SB(0, 1), cB + hstep, voffB); PG8_STAGE(PG8_SA(0, 1), cA + hstep, voffA);
        if (wr == 1) PG8_BAR;
        PG8_WAIT_V(4); PG8_BAR;
        PG8_STAGE(PG8_SB(1, 0), cB + kstep, voffB); PG8_STAGE(PG8_SA(1, 0), cA + kstep, voffA); PG8_STAGE(PG8_SB(1, 1), cB + hstep + kstep, voffB);
        PG8_WAIT_V(6); PG8_BAR;
    }
    for (;;) {
        const bool has_next = S.next(ui + 1, nxt);
        const char* nA = has_next ? (const char*)g.A + (size_t)nxt.pm * tstep : cA; const char* nB = has_next ? (const char*)g.Bt + (size_t)nxt.pn * tstep : cB;
        for (int t = 0; t < nt; t += 2) {
            const bool last = (t == nt - 2);
            const int rlx = (Epi::EPI_STORES >= 16 && t == 0 && ui > 0) ? 1 : 0;
            if constexpr (Epi::SCALE_AT >= 0) { if (t == Epi::SCALE_AT) E.scale(acc, cur, wr, wc, fr, fq); }
            const char* a1 = cA + (size_t)(t + 1) * kstep;
            const char* a2 = last ? nA : cA + (size_t)(t + 2) * kstep; const char* b2 = last ? nB : cB + (size_t)(t + 2) * kstep;
            const char* a3 = a2 + kstep; const char* b3 = b2 + kstep;
            if (last && has_next) S.a_ready(nxt);
            if constexpr (SP2) {
            PG8_LDB(B0, 0, 0); PG8_LDB(B1, 0, 1); PG8_SCHED; PG8_LDA(At, 0, 0); PG8_STAGE(PG8_SA(1, 1), a1 + hstep, voffA);
            PG8_WAIT_V_SEL(rlx); PG8_WAIT_L(0); PG8_BAR; PG8_MMA(0, 0, At, B0); PG8_MMA(0, 1, At, B1); PG8_BAR; PG8_SCHED;
            PG8_LDA(At, 0, 1); PG8_STAGE(PG8_SB(0, 0), b2, voffB); PG8_STAGE(PG8_SB(0, 1), b2 + hstep, voffB); PG8_STAGE(PG8_SA(0, 0), a2, voffA);
            PG8_WAIT_V_SEL(rlx); PG8_WAIT_L(0); PG8_BAR; PG8_MMA(1, 0, At, B0); PG8_MMA(1, 1, At, B1); PG8_BAR; PG8_SCHED;
            PG8_LDB(B0, 1, 0); PG8_LDB(B1, 1, 1); PG8_SCHED; PG8_LDA(At, 1, 0); PG8_STAGE(PG8_SA(0, 1), a2 + hstep, voffA);
            PG8_WAIT_V(8); PG8_WAIT_L(0); PG8_BAR; PG8_MMA(0, 0, At, B0); PG8_MMA(0, 1, At, B1); PG8_BAR; PG8_SCHED;
            PG8_LDA(At, 1, 1); PG8_STAGE(PG8_SB(1, 0), b3, voffB); PG8_STAGE(PG8_SB(1, 1), b3 + hstep, voffB); PG8_STAGE(PG8_SA(1, 0), a3, voffA);
            PG8_WAIT_V(8); PG8_WAIT_L(0); PG8_BAR; PG8_MMA(1, 0, At, B0); PG8_MMA(1, 1, At, B1); PG8_BAR; PG8_SCHED;
            } else {
            PG8_LDB(B0, 0, 0); PG8_SCHED; PG8_LDA(At, 0, 0); PG8_STAGE(PG8_SA(1, 1), a1 + hstep, voffA);
            PG8_WAIT_L(8); PG8_BAR; PG8_WAIT_L(0); PG8_MMA(0, 0, At, B0); PG8_BAR; PG8_SCHED;
            PG8_LDB(B1, 0, 1); PG8_STAGE(PG8_SB(0, 0), b2, voffB);
            PG8_BAR; PG8_WAIT_L(0); PG8_MMA(0, 1, At, B1); PG8_BAR;
            PG8_LDA(At, 0, 1); PG8_STAGE(PG8_SA(0, 0), a2, voffA);
            PG8_BAR; PG8_WAIT_L(0); PG8_MMA(1, 0, At, B0); PG8_BAR; PG8_SCHED;
            PG8_STAGE(PG8_SB(0, 1), b2 + hstep, voffB);
            PG8_WAIT_V(6); PG8_BAR; PG8_MMA(1, 1, At, B1); PG8_BAR;
            PG8_LDB(B0, 1, 0); PG8_SCHED; PG8_LDA(At, 1, 0); PG8_STAGE(PG8_SA(0, 1), a2 + hstep, voffA);
            PG8_WAIT_L(8); PG8_BAR; PG8_WAIT_L(0); PG8_MMA(0, 0, At, B0); PG8_BAR; PG8_SCHED;
            PG8_LDB(B1, 1, 1); PG8_STAGE(PG8_SB(1, 0), b3, voffB);
            PG8_BAR; PG8_WAIT_L(0); PG8_MMA(0, 1, At, B1); PG8_BAR;
            PG8_LDA(At, 1, 1); PG8_STAGE(PG8_SA(1, 0), a3, voffA);
            PG8_BAR; PG8_WAIT_L(0); PG8_MMA(1, 0, At, B0); PG8_BAR; PG8_SCHED;
            PG8_STAGE(PG8_SB(1, 1), b3 + hstep, voffB);
            PG8_WAIT_V(6); PG8_BAR; PG8_MMA(1, 1, At, B1); PG8_BAR;
            }
        }
        if constexpr (ALIGN_EPI) { if (wr == 0) PG8_BAR; }
        if constexpr (!Epi::AFTER_DRAIN) { E(acc, cur, wr, wc, fr, fq); S.done(cur); }
        if (!has_next) break;
#pragma unroll
        for (int a = 0; a < 2; ++a)
#pragma unroll
            for (int b = 0; b < 2; ++b)
#pragma unroll
                for (int m = 0; m < 4; ++m)
#pragma unroll
                    for (int n = 0; n < 2; ++n) acc[a][b][m][n] = (f32x4){0.f, 0.f, 0.f, 0.f};
        cur = nxt; cA = nA; cB = nB; ++ui;
        if constexpr (ALIGN_EPI) { if (wr == 1) PG8_BAR; }
    }
    PG8_WAIT_V(0);
    if constexpr (!ALIGN_EPI) { if (wr == 0) PG8_BAR; }
    PG8_BAR;
    if constexpr (Epi::AFTER_DRAIN) { E.fused(acc, cur, wr, wc, fr, fq, lds, wid, lane); S.done(cur); }
#undef PG8_SA
#undef PG8_SB
#undef PG8_STAGE
#undef PG8_LDA
#undef PG8_LDB
#undef PG8_MMA
#undef PG8_WAIT_V
#undef PG8_WAIT_L
#undef PG8_BAR
#undef PG8_SCHED
}
}
#define GAS __attribute__((address_space(1)))
#define LAS __attribute__((address_space(3)))
typedef unsigned short bf16;
typedef unsigned v4u __attribute__((ext_vector_type(4)));
typedef float f32x4 __attribute__((ext_vector_type(4)));
typedef short bf16x8 __attribute__((ext_vector_type(8)));
typedef GAS unsigned gu32;
typedef GAS unsigned long long gu64;
#define RLX_AGENT __ATOMIC_RELAXED, __HIP_MEMORY_SCOPE_AGENT
#define LDS_WAIT() asm volatile("s_waitcnt lgkmcnt(0)" ::: "memory")
#define VM_WAIT() asm volatile("s_waitcnt vmcnt(0)" ::: "memory")
__device__ __forceinline__ unsigned long long rt() { return __builtin_amdgcn_s_memrealtime(); }
__device__ __forceinline__ unsigned f2bf(float f) { unsigned u = __builtin_bit_cast(unsigned, f); return (u + 0x7fffu + ((u >> 16) & 1u)) >> 16; }
__device__ __forceinline__ unsigned pk2(float lo, float hi) { return f2bf(lo) | (f2bf(hi) << 16); }

constexpr int NB = 2, SEQ = 16384, T = NB * SEQ, DM = 2048, INW = 5632;
constexpr int AH = 16, AHD = 64, AW = 1024, AKW = 256;
constexpr int RH = 8, RDK = 64, RDV = 128, RQW = 512, RW = 1024, CH = 128, NC = SEQ / CH;
constexpr float EPS = 1e-6f, LOG2E = 1.4426950408889634f;
constexpr int BIAS_LD = 260;
constexpr int NWAVES = 8;

constexpr size_t MiB = 1u << 20;
constexpr size_t WS_CTL = 0, CTL_ZERO_BYTES = 32768;
constexpr size_t WS_COS = 1 * MiB, WS_SIN = 3 * MiB;
constexpr size_t WS_DEC = 5 * MiB;
constexpr size_t WS_BIAS = 5 * MiB + 65536;
constexpr size_t WS_SINK = 5 * MiB + 131072;
constexpr size_t WS_GAM = 5 * MiB + 131072 + 256;
constexpr size_t WS_WIN = 8 * MiB;
constexpr size_t WS_WO = 30 * MiB;
constexpr size_t WS_XN = 40 * MiB;
constexpr size_t WS_MIX = WS_XN;
constexpr size_t WS_QA = 168 * MiB, WS_KA = 232 * MiB, WS_VA = 248 * MiB, WS_GA = 264 * MiB;
constexpr size_t WS_QF = 328 * MiB, WS_QB = 360 * MiB, WS_KF = 392 * MiB, WS_KB = 424 * MiB, WS_VR = 456 * MiB, WS_GR = 520 * MiB;
constexpr size_t WS_SSQ = 648 * MiB;
constexpr size_t WS_G = 652 * MiB;
constexpr size_t WS_ST = 780 * MiB;
constexpr size_t WS_DLT = 848 * MiB;
constexpr size_t WS_END = 976 * MiB;
constexpr int CW_TMO = 0, CW_CODE = 1, CW_BAR = 4096;

constexpr int RING_OFF = 0, RING_BYTES = 131072;
constexpr int LDSCTL_OFF = 139264, MISC_OFF = LDSCTL_OFF + 320;
constexpr int LDS_BYTES = 147456;
#define XB_TMO      128
#define XB_XCNT(j)  (256  + 64 * (j))
#define XB_XSUB(j)  (1280 + 64 * (j))
#define XB_XGEN(j)  (2304 + 64 * (j))
#define XB_TOP      3328
#define XB_TOPGEN   3392
#define XCD_BAR_WORDS 3456
#define XB_SPIN_CAP (1u << 24)

__device__ __forceinline__ unsigned xb_ld(unsigned* p)              { return __hip_atomic_load(p, __ATOMIC_RELAXED, __HIP_MEMORY_SCOPE_AGENT); }
__device__ __forceinline__ unsigned xb_add(unsigned* p, unsigned v) { return __hip_atomic_fetch_add(p, v, __ATOMIC_RELAXED, __HIP_MEMORY_SCOPE_AGENT); }
__device__ __forceinline__ unsigned xb_xcc_id() { return (unsigned)__builtin_amdgcn_s_getreg((3 << 11) | 20) & 0xFu; }
#define XB_SPIN(cond, bar) do { unsigned _sp = 0; while (cond) { __builtin_amdgcn_s_sleep(1); \
    if ((++_sp & 255u) == 0u) { if (xb_ld(&(bar)[XB_TMO])) break; if (_sp > XB_SPIN_CAP) { atomicAdd(&(bar)[XB_TMO], 1u); break; } } } } while (0)

struct XcdBarrier {
    unsigned* bar; unsigned x;
    volatile LAS unsigned* st;
};

__device__ __forceinline__ XcdBarrier xcd_barrier_post(unsigned* bar, volatile LAS unsigned* st) {
    XcdBarrier b; b.bar = bar; b.x = xb_xcc_id(); b.st = st;
    if (threadIdx.x == 0) (void)xb_add(&bar[XB_XCNT(b.x)], 1u);
    return b;
}
__device__ __forceinline__ void xcd_barrier_complete(unsigned* bar, unsigned x, unsigned& nloc, unsigned& nx) {
    const unsigned G = gridDim.x * gridDim.y * gridDim.z;
    unsigned sum, cnt, mine, sp = 0u;
    for (;;) {
        sum = 0u; cnt = 0u; mine = 0u;
#pragma unroll
        for (unsigned j = 0; j < 16; ++j) { const unsigned c = xb_ld(&bar[XB_XCNT(j)]); sum += c; cnt += (c > 0u) ? 1u : 0u; mine = (j == x) ? c : mine; }
        if (sum == G) break;
        __builtin_amdgcn_s_sleep(1);
        if ((++sp & 255u) == 0u) { if (xb_ld(&bar[XB_TMO])) break; if (sp > XB_SPIN_CAP) { atomicAdd(&bar[XB_TMO], 1u); break; } }
    }
    nloc = mine > 0u ? mine : 1u; nx = cnt > 0u ? cnt : 1u;
}

__device__ __forceinline__ void xcd_barrier(const XcdBarrier& b) {
    asm volatile("s_waitcnt vmcnt(0)" ::: "memory");
    __syncthreads();
    if (threadIdx.x == 0) {
        unsigned* bar = b.bar;
        __builtin_amdgcn_s_waitcnt(0);
        unsigned nloc = b.st[0], nx = b.st[1];
        if (nloc == 0u) { xcd_barrier_complete(bar, b.x, nloc, nx); b.st[0] = nloc; b.st[1] = nx; }
        const unsigned old = xb_add(&bar[XB_XSUB(b.x)], 1u);
        const unsigned gen = old / nloc;
        if (old + 1u == (gen + 1u) * nloc) {
            __builtin_amdgcn_fence(__ATOMIC_RELEASE, "agent");
            asm volatile("s_waitcnt vmcnt(0)" ::: "memory");
            const unsigned og = xb_add(&bar[XB_TOP], 1u);
            const unsigned tg = og / nx;
            if (og + 1u == (tg + 1u) * nx) xb_add(&bar[XB_TOPGEN], 1u);
            else XB_SPIN(xb_ld(&bar[XB_TOPGEN]) == tg, bar);
            __builtin_amdgcn_fence(__ATOMIC_ACQUIRE, "agent");
            xb_add(&bar[XB_XGEN(b.x)], 1u);
            asm volatile("s_waitcnt vmcnt(0)" ::: "memory");
        } else {
            XB_SPIN(xb_ld(&bar[XB_XGEN(b.x)]) == gen, bar);
            __builtin_amdgcn_fence(__ATOMIC_ACQUIRE, "agent");
            asm volatile("s_waitcnt vmcnt(0)" ::: "memory");
        }
    }
    __syncthreads();
}

struct Ptrs {
    const float *x, *norm_w, *w_in, *sink, *rel_bias, *aon_w, *dec_f, *dec_b, *gn_w, *w_out, *fin_w;
    float* out;
    bf16 *win_t, *wo_t, *xn, *mix, *qa, *ka, *va, *ga, *qf, *qb, *kf, *kb, *vr, *gr, *st, *dlt;
    float *cosT, *sinT, *decT, *biasT, *sink2, *gam, *ssq, *ra; bf16* G;
};
typedef unsigned u32x2 __attribute__((ext_vector_type(2)));
__device__ __forceinline__ float bflo(unsigned w) { return __builtin_bit_cast(float, w << 16); }
__device__ __forceinline__ float bfhi(unsigned w) { return __builtin_bit_cast(float, w & 0xffff0000u); }
__device__ __forceinline__ float bf2f(bf16 h) { return __builtin_bit_cast(float, (unsigned)h << 16); }
__device__ __forceinline__ float wave_sum(float v) {
#pragma unroll
    for (int o = 1; o < 64; o <<= 1) v += __shfl_xor(v, o);
    return v;
}
__device__ __forceinline__ float wave_max(float v) {
#pragma unroll
    for (int o = 1; o < 64; o <<= 1) v = fmaxf(v, __shfl_xor(v, o));
    return v;
}
__device__ __forceinline__ float silu_f(float v) { return v * __builtin_amdgcn_rcpf(1.0f + __builtin_amdgcn_exp2f(-v * LOG2E)); }
__device__ __forceinline__ void unpack8(const v4u w, float (&f)[8]) {
    f[0] = bflo(w.x); f[1] = bfhi(w.x); f[2] = bflo(w.y); f[3] = bfhi(w.y); f[4] = bflo(w.z); f[5] = bfhi(w.z); f[6] = bflo(w.w); f[7] = bfhi(w.w);
}
__device__ __forceinline__ v4u pack8(const float (&f)[8]) {
    v4u w; w.x = pg8::cvt_pk_bf16(f[0], f[1]); w.y = pg8::cvt_pk_bf16(f[2], f[3]); w.z = pg8::cvt_pk_bf16(f[4], f[5]); w.w = pg8::cvt_pk_bf16(f[6], f[7]); return w;
}

__device__ __forceinline__ v4u scale8(const v4u w, float sc) { float f[8]; unpack8(w, f);
#pragma unroll
    for (int k = 0; k < 8; ++k) f[k] *= sc;
    return pack8(f); }

__device__ __forceinline__ void p0_transpose_item(const float* W, int K, int N, bf16* WT, LAS float* scr, int item, int lane) {
    const int nblk = N / 32, kb = item / nblk, nb = item % nblk, k0 = 64 * kb, n0 = 32 * nb;
#pragma unroll 8
    for (int i = 0; i < 32; ++i) { const int kk = 2 * i + (lane >> 5); scr[kk * 33 + (lane & 31)] = __builtin_nontemporal_load(W + (size_t)(k0 + kk) * N + n0 + (lane & 31)); }
    LDS_WAIT(); asm volatile("" ::: "memory");
    const int c = lane & 7;
#pragma unroll
    for (int j = 0; j < 4; ++j) { const int n = (lane >> 3) + 8 * j; const LAS float* s = scr + (8 * c) * 33 + n;
        v4u o; o.x = pk2(s[0 * 33], s[1 * 33]); o.y = pk2(s[2 * 33], s[3 * 33]); o.z = pk2(s[4 * 33], s[5 * 33]); o.w = pk2(s[6 * 33], s[7 * 33]);
        *(GAS v4u*)(WT + (size_t)(n0 + n) * K + k0 + 8 * c) = o; }
    LDS_WAIT(); asm volatile("" ::: "memory");
}
__device__ __forceinline__ int t5_bucket(int rel) {
    const int n = rel < 0 ? -rel : rel; int b;
    if (n < 8) b = n; else if (n < 12) b = 8; else if (n < 16) b = 9; else if (n < 23) b = 10; else if (n < 32) b = 11;
    else if (n < 46) b = 12; else if (n < 64) b = 13; else if (n < 91) b = 14; else b = 15;
    return b + (rel > 0 ? 16 : 0);
}
__device__ __forceinline__ void p0_prologue(const Ptrs& P, LAS unsigned char* lds, int gw, int NGW, int wave, int lane) {
    LAS float* scr = (LAS float*)(lds + RING_OFF + wave * 16384);
    constexpr int I_IN = (DM / 64) * (INW / 32), I_OUT = (DM / 64) * (DM / 32);
    for (int it = gw; it < I_IN + I_OUT; it += NGW) {
        if (it < I_IN) p0_transpose_item(P.w_in, DM, INW, P.win_t, scr, it, lane);
        else p0_transpose_item(P.w_out, DM, DM, P.wo_t, scr, it - I_IN, lane);
    }
    {
        f32x4 wv[8];
        { const GAS f32x4* wr_ = (const GAS f32x4*)P.norm_w + lane;
#pragma unroll
          for (int j = 0; j < 8; ++j) wv[j] = wr_[64 * j]; }
        for (int m = gw; m < T; m += 2 * NGW) {
            const int m2 = m + NGW;
            const bool has2 = m2 < T;
            const GAS f32x4* xa = (const GAS f32x4*)(P.x + (size_t)m * DM) + lane; const GAS f32x4* xb = (const GAS f32x4*)(P.x + (size_t)(has2 ? m2 : m) * DM) + lane;
            f32x4 va[8], vb[8]; float sa_ = 0.f, sb_ = 0.f;
#pragma unroll
            for (int j = 0; j < 8; ++j) { va[j] = __builtin_nontemporal_load(xa + 64 * j); vb[j] = __builtin_nontemporal_load(xb + 64 * j); }
#pragma unroll
            for (int j = 0; j < 8; ++j) { sa_ += (va[j].x * va[j].x + va[j].y * va[j].y) + (va[j].z * va[j].z + va[j].w * va[j].w); sb_ += (vb[j].x * vb[j].x + vb[j].y * vb[j].y) + (vb[j].z * vb[j].z + vb[j].w * vb[j].w); }
            const float ra = 1.0f / sqrtf(wave_sum(sa_) * (1.f / DM) + EPS), rb = 1.0f / sqrtf(wave_sum(sb_) * (1.f / DM) + EPS);
            GAS u32x2* oa = (GAS u32x2*)(P.xn + (size_t)m * DM) + lane; GAS u32x2* ob = (GAS u32x2*)(P.xn + (size_t)m2 * DM) + lane;
#pragma unroll
            for (int j = 0; j < 8; ++j) { const f32x4 w = wv[j]; u32x2 o; o.x = pk2(va[j].x * ra * w.x, va[j].y * ra * w.y); o.y = pk2(va[j].z * ra * w.z, va[j].w * ra * w.w); oa[64 * j] = o;
                if (has2) { u32x2 o2; o2.x = pk2(vb[j].x * rb * w.x, vb[j].y * rb * w.y); o2.y = pk2(vb[j].z * rb * w.z, vb[j].w * rb * w.w); ob[64 * j] = o2; } }
        }
    }
    const int gt = gw * 64 + lane, NGT = NGW * 64;
    for (int idx = gt; idx < SEQ * 32; idx += NGT) {
        const int pos = idx >> 5, j = idx & 31;
        const float inv = exp2f(-((float)(2 * j) / 64.0f) * 13.287712379549449f);
        const float ang = (float)pos * inv;
        const double rev = (double)ang * 0.15915494309189535;
        const float fr = (float)(rev - floor(rev));
        P.cosT[idx] = __builtin_amdgcn_cosf(fr); P.sinT[idx] = __builtin_amdgcn_sinf(fr);
    }
    for (int idx = gt; idx < 4 * 8 * 128; idx += NGT) {
        const int kind = idx >> 10, h = (idx >> 7) & 7, i = idx & 127;
        const float lf = -log1pf(expf(-P.dec_f[h])), lb = -log1pf(expf(-P.dec_b[h]));
        float v;
        if (kind == 0) v = expf(lf * (float)i); else if (kind == 1) v = expf(-lb * (float)i);
        else if (kind == 2) v = expf(-lf * (float)i); else v = expf(lb * (float)i);
        P.decT[idx] = v;
    }
    for (int idx = gt; idx < 16 * BIAS_LD; idx += NGT) {
        const int h = idx / BIAS_LD, r = idx % BIAS_LD;
        P.biasT[idx] = (r <= 256) ? P.rel_bias[t5_bucket(r - 128) * 16 + h] * LOG2E : 0.f;
    }
    if (gt < 16) P.sink2[gt] = P.sink[gt] * LOG2E;
    if (gt < 16) { const int h = gt & 7; const float d = (gt < 8) ? P.dec_f[h] : P.dec_b[h]; P.gam[gt] = expf(-log1pf(expf(-d)) * 128.0f); }
}

#ifndef P1_ST_AUX
#define P1_ST_AUX 18
#endif
__device__ __forceinline__ void st16_aux(void* base, unsigned byte_off, const v4u v) {
    const __amdgpu_buffer_rsrc_t r = __builtin_amdgcn_make_buffer_rsrc((void*)base, (short)0, 0x7ffffff0, 0x00020000);
    __builtin_amdgcn_raw_buffer_store_b128(v, r, byte_off, 0, P1_ST_AUX);
}
struct EpiIn {
    static constexpr bool PERM = true, AFTER_DRAIN = false; static constexpr int SCALE_AT = -1, EPI_STORES = 16;
    bf16 *qa, *ka, *va, *ga, *qf, *qb, *kf, *kb, *vr, *gr; const float *cosT, *sinT, *decT;
    __device__ __forceinline__ void operator()(const pg8::f32x4 (&acc)[2][2][4][2], const pg8::Unit& u, int wr, int wc, int fr, int fq) const {
        const int pn = u.pn, row0 = u.pm * 256 + wr * 64 + fr, cl = wc * 32 + 8 * fq;
        if (pn >= 10 && pn < 14) {
            const bool isq = pn < 12; const int csec0 = (isq ? pn - 10 : pn - 12) * 256 + cl;
            bf16* oA = isq ? qf : kf; const float ksc = isq ? 1.0f : 0.125f;
            f32x4 c4[2][4], s4[2][4];
            const int p0 = (csec0 & 63) >> 1;
#pragma unroll
            for (int ai = 0; ai < 2; ++ai)
#pragma unroll
                for (int m = 0; m < 4; ++m) { const int pos = (row0 + ai * 128 + m * 16) & (SEQ - 1); c4[ai][m] = *(const f32x4*)(cosT + pos * 32 + p0); s4[ai][m] = *(const f32x4*)(sinT + pos * 32 + p0); }
            __builtin_amdgcn_sched_barrier(0);
#pragma unroll
            for (int ai = 0; ai < 2; ++ai) {
#pragma unroll
                for (int m = 0; m < 4; ++m) { const int row = row0 + ai * 128 + m * 16;
#pragma unroll
                    for (int bj = 0; bj < 2; ++bj) { const int csec = csec0 + bj * 128;
                        const pg8::f32x4 v0 = acc[ai][bj][m][0], v1 = acc[ai][bj][m][1]; const f32x4 cc = c4[ai][m] * ksc, sn = s4[ai][m] * ksc;
                        float y[8];
                        y[0] = v0[0] * cc[0] - v0[1] * sn[0]; y[1] = v0[0] * sn[0] + v0[1] * cc[0];
                        y[2] = v0[2] * cc[1] - v0[3] * sn[1]; y[3] = v0[2] * sn[1] + v0[3] * cc[1];
                        y[4] = v1[0] * cc[2] - v1[1] * sn[2]; y[5] = v1[0] * sn[2] + v1[1] * cc[2];
                        y[6] = v1[2] * cc[3] - v1[3] * sn[3]; y[7] = v1[2] * sn[3] + v1[3] * cc[3];
                        st16_aux(oA, (unsigned)(((size_t)row * RQW + csec) * 2), pack8(y)); } }
            }
            __builtin_amdgcn_sched_barrier(0);
        } else {
            bf16* base; int ldc, col0, mode;
            if (pn < 4) { base = qa; ldc = AW; col0 = pn * 256; mode = 1; }
            else if (pn == 4) { base = ka; ldc = AKW; col0 = 0; mode = 0; }
            else if (pn == 5) { base = va; ldc = AKW; col0 = 0; mode = 0; }
            else if (pn < 10) { base = ga; ldc = AW; col0 = (pn - 6) * 256; mode = 2; }
            else if (pn < 18) { base = vr; ldc = RW; col0 = (pn - 14) * 256; mode = 0; }
            else { base = gr; ldc = RW; col0 = (pn - 18) * 256; mode = 2; }
            const float sc = (mode == 1) ? 0.125f * LOG2E : 1.0f;
#pragma unroll
            for (int ai = 0; ai < 2; ++ai)
#pragma unroll
                for (int m = 0; m < 4; ++m) { const unsigned rowoff = (unsigned)(((size_t)(row0 + ai * 128 + m * 16) * ldc + col0 + cl) * 2);
#pragma unroll
                    for (int bj = 0; bj < 2; ++bj) { const pg8::f32x4 v0 = acc[ai][bj][m][0], v1 = acc[ai][bj][m][1];
                        float y[8] = {v0[0], v0[1], v0[2], v0[3], v1[0], v1[1], v1[2], v1[3]};
                        if (mode == 2) {
#pragma unroll
                            for (int k = 0; k < 8; ++k) y[k] = silu_f(y[k]);
                        } else {
#pragma unroll
                            for (int k = 0; k < 8; ++k) y[k] *= sc;
                        }
                        st16_aux(base, rowoff + bj * 256, pack8(y)); } }
        }
    }
};


struct EpiDelta {
    static constexpr bool PERM = true, AFTER_DRAIN = false; static constexpr int SCALE_AT = AW / 64, EPI_STORES = 16;
    bf16* dl; const float* ra;
    __device__ __forceinline__ void scale(pg8::f32x4 (&acc)[2][2][4][2], const pg8::Unit& u, int wr, int wc, int fr, int fq) const {
        const float* rp = ra + u.pm * 256 + wr * 64 + fr;
#pragma unroll
        for (int ai = 0; ai < 2; ++ai)
#pragma unroll
            for (int m = 0; m < 4; ++m) { const float r = rp[ai * 128 + m * 16];
#pragma unroll
                for (int bj = 0; bj < 2; ++bj)
#pragma unroll
                    for (int n = 0; n < 2; ++n) acc[ai][bj][m][n] *= r; }
    }
    __device__ __forceinline__ void operator()(const pg8::f32x4 (&acc)[2][2][4][2], const pg8::Unit& u, int wr, int wc, int fr, int fq) const {
        const int row0 = u.pm * 256 + wr * 64 + fr, col0 = u.pn * 256 + wc * 32 + 8 * fq;
#pragma unroll
        for (int ai = 0; ai < 2; ++ai)
#pragma unroll
            for (int m = 0; m < 4; ++m) { bf16* rowp = dl + (size_t)(row0 + ai * 128 + m * 16) * DM + col0;
#pragma unroll
                for (int bj = 0; bj < 2; ++bj) { const pg8::f32x4 v0 = acc[ai][bj][m][0], v1 = acc[ai][bj][m][1];
                    const float y[8] = {v0[0], v0[1], v0[2], v0[3], v1[0], v1[1], v1[2], v1[3]};
                    *(v4u*)(rowp + bj * 128) = pack8(y);     } }
    }
};
typedef float f32x16 __attribute__((ext_vector_type(16)));
typedef short s16x4 __attribute__((ext_vector_type(4)));
typedef short v4i16_t __attribute__((ext_vector_type(4)));
typedef LAS const char* lds_cptr;
__device__ __forceinline__ int crow(int r, int hi) { return (r & 3) + 8 * (r >> 2) + 4 * hi; }
__device__ __forceinline__ s16x4 vtr(lds_cptr p) { return __builtin_bit_cast(s16x4, __builtin_amdgcn_ds_read_tr16_b64_v4i16((LAS v4i16_t*)p)); }
__device__ __forceinline__ bf16x8 vtr8(lds_cptr p) { const s16x4 lo = vtr(p), hi_ = vtr(p + 512); return (bf16x8){lo[0], lo[1], lo[2], lo[3], hi_[0], hi_[1], hi_[2], hi_[3]}; }
__device__ __forceinline__ unsigned cvtpk(float lo, float hi) { typedef float f2_t __attribute__((ext_vector_type(2))); typedef __bf16 b2_t __attribute__((ext_vector_type(2))); f2_t v = {lo, hi}; b2_t b = __builtin_convertvector(v, b2_t); return __builtin_bit_cast(unsigned, b); }
__device__ __forceinline__ void half_swap(unsigned& a, unsigned& b) { asm volatile("s_nop 1\n\tv_permlane32_swap_b32 %0, %1" : "+v"(a), "+v"(b)); }
__device__ __forceinline__ float half_swap_max(float m) { unsigned a = __builtin_bit_cast(unsigned, m), b = a; half_swap(a, b); return fmaxf(__builtin_bit_cast(float, a), __builtin_bit_cast(float, b)); }
__device__ __forceinline__ float half_swap_sum(float m) { unsigned a = __builtin_bit_cast(unsigned, m), b = a; half_swap(a, b); return __builtin_bit_cast(float, a) + __builtin_bit_cast(float, b); }
#define LDS_BAR() asm volatile("s_waitcnt lgkmcnt(0)\n\ts_barrier" ::: "memory")
__device__ __forceinline__ float amax3(float a, float b, float c) { float r; asm("v_max3_f32 %0, %1, %2, %3" : "=v"(r) : "v"(a), "v"(b), "v"(c)); return r; }
#define MFMA32(a, b, c) __builtin_amdgcn_mfma_f32_32x32x16_bf16((a), (b), (c), 0, 0, 0)
#define PK8(p, B) __builtin_bit_cast(bf16x8, (v4u){cvtpk(p[B], p[B + 1]), cvtpk(p[B + 2], p[B + 3]), cvtpk(p[B + 4], p[B + 5]), cvtpk(p[B + 6], p[B + 7])})

constexpr int A_KT = 8192, A_KCS = 1040, A_KTS = 8 * A_KCS  , A_LK = 0, A_LV = 5 * A_KTS, A_LB = A_LV + 5 * A_KT, A_LWS = A_LB + 4 * 384 * 4, A_LOST = A_LWS + 8 * 64 * 4;
static_assert(A_LOST + 8 * 4096 <= RING_BYTES, "attention LDS map");
__device__ __forceinline__ void ret_scan(const Ptrs& P, int gt, int NGT);
__device__ __forceinline__ void attn_phase(const Ptrs& P, LAS unsigned char* lds, int vcu, int G, int gt, int NGT) {
    const int tid = threadIdx.x, lane = tid & 63, r32 = lane & 31, hi = lane >> 5, wid = __builtin_amdgcn_readfirstlane(tid >> 6), g = wid >> 1, sb = wid & 1;
    int cur_hk = -1;
    LAS float* wsf = (LAS float*)(lds + A_LWS) + wid * 64;
    constexpr int NU = NB * (SEQ / 64) * 4;
    v4u kreg[5], vreg[5]; bf16x8 qn[4];
#define ATT_LOAD(uu) do { const int hk_ = (uu) & 3, qb_ = ((uu) >> 2) & 255, b_ = (uu) >> 10, q0_ = qb_ * 64, tb_ = b_ * SEQ; \
        const int tlo_ = q0_ >= 128 ? 0 : (q0_ >= 64 ? 1 : 2); int thi_ = (SEQ + 128 - q0_) / 64; if (thi_ > 5) thi_ = 5; \
        const bf16* ksrc = P.ka + (size_t)(tb_ + q0_ - 128 + 8 * wid + (lane >> 3)) * AKW + hk_ * 64 + (lane & 7) * 8; \
        const bf16* vsrc = P.va + (size_t)(tb_ + q0_ - 128 + 8 * wid + (lane >> 3)) * AKW + hk_ * 64 + (lane & 7) * 8; \
        _Pragma("unroll") for (int t = 0; t < 5; ++t) if (t >= tlo_ && t < thi_) { kreg[t] = *(const v4u*)(ksrc + (size_t)t * 64 * AKW); vreg[t] = *(const v4u*)(vsrc + (size_t)t * 64 * AKW); } \
        } while (0)
#define ATT_LOADQ(uu) do { const int hk_ = (uu) & 3, qb_ = ((uu) >> 2) & 255, b_ = (uu) >> 10, q0_ = qb_ * 64, tb_ = b_ * SEQ; \
        const bf16* qp = P.qa + (size_t)(tb_ + q0_ + sb * 32 + r32) * AW + (hk_ * 4 + g) * 64 + hi * 8; \
        _Pragma("unroll") for (int d0 = 0; d0 < 4; ++d0) qn[d0] = __builtin_nontemporal_load((const bf16x8*)(qp + d0 * 16)); } while (0)
    if (vcu < NU) { ATT_LOAD(vcu); ATT_LOADQ(vcu); }
    ret_scan(P, gt, NGT);
    for (int u = vcu; u < NU; u += G) {
        const int hk = u & 3, qb = (u >> 2) & 255, b = u >> 10;
        const int q0 = qb * 64, tb = b * SEQ, h = hk * 4 + g;
        const int tlo = q0 >= 128 ? 0 : (q0 >= 64 ? 1 : 2);
        int thi = (SEQ + 128 - q0) / 64; if (thi > 5) thi = 5;
        LDS_BAR();
        if (hk != cur_hk) {
            for (int e = tid; e < 4 * 384; e += NWAVES * 64) { const int gg = e / 384, i = e % 384, r128 = i - 63;
                ((LAS float*)(lds + A_LB))[e] = (r128 >= 0 && r128 <= 256) ? P.biasT[(hk * 4 + gg) * BIAS_LD + r128] - P.sink2[hk * 4 + gg] : -1e30f; }
            cur_hk = hk;
        }
#pragma unroll
        for (int t = 0; t < 5; ++t) if (t >= tlo && t < thi) { const int row = 8 * wid + (lane >> 3), pc = lane & 7;
            *(LAS v4u*)(lds + A_LK + t * A_KTS + pc * A_KCS + row * 16) = kreg[t];
            *(LAS v4u*)(lds + A_LV + t * A_KT + ((pc >> 2) * 4 + (row >> 4)) * 1024 + (row & 15) * 64 + (pc & 3) * 16) = vreg[t]; }
        bf16x8 qr[4];
#pragma unroll
        for (int d0 = 0; d0 < 4; ++d0) qr[d0] = qn[d0];
        const float sink = P.sink2[h];
        LDS_BAR();
        v4u gv[4];
#pragma unroll
        for (int i = 0; i < 4; ++i) gv[i] = __builtin_nontemporal_load((const v4u*)(P.ga + (size_t)(tb + q0 + sb * 32 + i * 8 + (lane >> 3)) * AW + h * 64 + (lane & 7) * 8));
        const f32x4 aw0 = *(const f32x4*)(P.aon_w + h * 64 + (lane & 7) * 8), aw1 = *(const f32x4*)(P.aon_w + h * 64 + (lane & 7) * 8 + 4);
        if (u + G < NU) ATT_LOAD(u + G);
        float moff = 0.f, l = 0.f; f32x16 o0 = {}, o1 = {}; bool shifted = false;
        unsigned btoff = (unsigned)(size_t)((const LAS float*)(lds + A_LB) + g * 384 + 63 - (sb * 32 + r32) + 4 * hi) + 256u * (unsigned)tlo;
        asm volatile("" : "+v"(btoff));
        bool guard = false;
        f32x16 p0, p1;
#define ATT_CINIT() do { const LAS float* bb = (const LAS float*)(size_t)btoff; _Pragma("unroll") for (int r = 0; r < 16; ++r) { p0[r] = bb[(r & 3) + 8 * (r >> 2)]; p1[r] = bb[32 + (r & 3) + 8 * (r >> 2)]; } } while (0)
        ATT_CINIT();
#pragma unroll 1
        for (int t = tlo; t < thi;) {
            const lds_cptr kb_ = (lds_cptr)(lds + A_LK + t * A_KTS) + hi * A_KCS + r32 * 16;
            bf16x8 kf[8];
#pragma unroll
            for (int d0 = 0; d0 < 4; ++d0) { kf[2 * d0] = *(const LAS bf16x8*)(kb_ + d0 * 2 * A_KCS); kf[2 * d0 + 1] = *(const LAS bf16x8*)(kb_ + d0 * 2 * A_KCS + 512); }
            __builtin_amdgcn_sched_barrier(0);
#pragma unroll
            for (int d0 = 0; d0 < 4; ++d0) { p0 = MFMA32(kf[2 * d0], qr[d0], p0); p1 = MFMA32(kf[2 * d0 + 1], qr[d0], p1); }
            const lds_cptr vp = (lds_cptr)(lds + A_LV + t * A_KT) + ((lane >> 4) & 1) * 32 + (lane & 3) * 8 + (4 * hi + ((lane & 15) >> 2)) * 64;
            if (shifted) {
#pragma unroll
                for (int r = 0; r < 16; ++r) { p0[r] -= moff; p1[r] -= moff; }
            }
            if (guard) {
                float rm = amax3(p0[0], p1[0], p0[1]);
#pragma unroll
                for (int r = 1; r < 15; ++r) rm = amax3(rm, p1[r], p0[r + 1]);
                rm = amax3(rm, p1[15], rm);
                rm = half_swap_max(rm);
                if (__any(rm > 0.f)) {
                    const float dl = fmaxf(rm, 0.f), f = __builtin_amdgcn_exp2f(-dl); l *= f; moff += dl; shifted = true;
                    if (hi == 0) wsf[r32] = f;
#pragma unroll
                    for (int r = 0; r < 16; ++r) { const float fr_ = wsf[crow(r, hi)]; o0[r] *= fr_; o1[r] *= fr_; p0[r] -= dl; p1[r] -= dl; }
                }
            }
            float ps = 0.f;
#pragma unroll
            for (int r = 0; r < 16; ++r) { p0[r] = __builtin_amdgcn_exp2f(p0[r]); p1[r] = __builtin_amdgcn_exp2f(p1[r]); ps += p0[r] + p1[r]; }
            if (!guard && __any(!(ps <= 0x1p64f))) { guard = true; ATT_CINIT(); continue; }
            l += ps;
            const bf16x8 pa0 = PK8(p0, 0), pa1 = PK8(p0, 8), pa2 = PK8(p1, 0), pa3 = PK8(p1, 8);
            btoff += 256u; ++t;
            __builtin_amdgcn_sched_barrier(0);
            ATT_CINIT();
            bf16x8 vb[8];
#pragma unroll
            for (int i = 0; i < 4; ++i) { vb[2 * i] = vtr8(vp + i * 1024); vb[2 * i + 1] = vtr8(vp + 4096 + i * 1024); }
            __builtin_amdgcn_sched_barrier(0);
            o0 = MFMA32(pa0, vb[0], o0); o1 = MFMA32(pa0, vb[1], o1);
            o0 = MFMA32(pa1, vb[2], o0); o1 = MFMA32(pa1, vb[3], o1);
            o0 = MFMA32(pa2, vb[4], o0); o1 = MFMA32(pa2, vb[5], o1);
            o0 = MFMA32(pa3, vb[6], o0); o1 = MFMA32(pa3, vb[7], o1);
        }
#undef ATT_CINIT
        if (u + G < NU) ATT_LOADQ(u + G);
        l = half_swap_sum(l) + __builtin_amdgcn_exp2f(-moff);
        if (hi == 0) wsf[32 + r32] = 1.0f / l;
        LAS bf16* stg = (LAS bf16*)(lds + A_LOST) + wid * 2048;
#pragma unroll
        for (int r = 0; r < 16; ++r) { const int orow = crow(r, hi); const float il = wsf[32 + orow];
            stg[orow * 64 + r32] = (bf16)f2bf(o0[r] * il); stg[orow * 64 + 32 + r32] = (bf16)f2bf(o1[r] * il); }
        asm volatile("s_waitcnt lgkmcnt(0)" ::: "memory");
        bf16* ow = P.mix + (size_t)(tb + q0 + sb * 32) * DM + h * 64;
        const float awv[8] = {aw0.x, aw0.y, aw0.z, aw0.w, aw1.x, aw1.y, aw1.z, aw1.w};
        float ssv[4];
#pragma unroll
        for (int i = 0; i < 4; ++i) { const int row = i * 8 + (lane >> 3), ch = lane & 7; const v4u v = *(const LAS v4u*)(stg + row * 64 + ch * 8);
            float a[8], g8[8], y[8]; unpack8(v, a); unpack8(gv[i], g8); float ss = 0.f;
#pragma unroll
            for (int k = 0; k < 8; ++k) { ss += a[k] * a[k]; y[k] = a[k] * awv[k] * g8[k]; }
            ss += __shfl_xor(ss, 1); ss += __shfl_xor(ss, 2); ss += __shfl_xor(ss, 4); ssv[i] = ss;
            *(v4u*)(ow + (size_t)row * DM + ch * 8) = pack8(y); }
        if ((lane & 7) == 0) {
#pragma unroll
            for (int i = 0; i < 4; ++i) P.ssq[(size_t)(tb + q0 + sb * 32 + i * 8 + (lane >> 3)) * 16 + h] = ssv[i];
        }
    }
#undef ATT_LOAD
#undef ATT_LOADQ
}
__device__ __forceinline__ v4u ldg16(const void* sbase, unsigned voff) { return __builtin_nontemporal_load((const v4u*)((const char*)sbase + voff)); }
constexpr int R1_LV = 0, R1_LKF = 32768, R1_LKB = 49152;
__device__ __forceinline__ void ret_kv_phase(const Ptrs& P, LAS unsigned char* lds, int vcu, int G) {
    const int tid = threadIdx.x, lane = tid & 63, r32 = lane & 31, hi = lane >> 5, wid = __builtin_amdgcn_readfirstlane(tid >> 6), dir = wid & 1, dvb = wid >> 1;
    const int trbase = ((lane >> 4) & 1) * 32 + (lane & 3) * 8 + (4 * hi + ((lane & 15) >> 2)) * 64;
    constexpr int NU = NB * RH * NC;
    const unsigned vrow0 = (unsigned)tid >> 4, vpc = (unsigned)tid & 15, krow0 = (unsigned)tid >> 3, kpc = (unsigned)tid & 7;
    const unsigned vo_v = vrow0 * (RW * 2) + vpc * 16, vo_k = krow0 * (RQW * 2) + kpc * 16;
    v4u vv[4], krv[2]; float dsf[2], dsb[2];
#define R1_LOAD(uu) do { const int c_ = (uu) & 127, h_ = ((uu) >> 7) & 7, b_ = (uu) >> 10; const size_t t0_ = (size_t)b_ * SEQ + c_ * CH; \
        _Pragma("unroll") for (int i = 0; i < 4; ++i) vv[i] = ldg16(P.vr + (t0_ + 32 * i) * RW + h_ * RDV, vo_v); \
        _Pragma("unroll") for (int i = 0; i < 2; ++i) { krv[i] = ldg16(P.kf + (t0_ + 64 * i) * RQW + h_ * RDK, vo_k); dsf[i] = P.decT[2 * 1024 + h_ * 128 + krow0 + 64 * i]; dsb[i] = P.decT[3 * 1024 + h_ * 128 + krow0 + 64 * i]; } } while (0)
    if (vcu < NU) R1_LOAD(vcu);
    for (int u = vcu; u < NU; u += G) {
        const int c = u & 127, h = (u >> 7) & 7, b = u >> 10;
        LDS_BAR();
#pragma unroll
        for (int i = 0; i < 4; ++i) { const int row = vrow0 + 32 * i; *(LAS v4u*)(lds + R1_LV + ((vpc >> 2) * 8 + (row >> 4)) * 1024 + (row & 15) * 64 + (vpc & 3) * 16) = vv[i]; }
#pragma unroll
        for (int i = 0; i < 2; ++i) { const int row = krow0 + 64 * i, off = ((kpc >> 2) * 8 + (row >> 4)) * 1024 + (row & 15) * 64 + (kpc & 3) * 16;
            *(LAS v4u*)(lds + R1_LKF + off) = scale8(krv[i], dsf[i]); *(LAS v4u*)(lds + R1_LKB + off) = scale8(krv[i], dsb[i]); }
        LDS_BAR();
        if (u + G < NU) R1_LOAD(u + G);
        f32x16 a0 = {}, a1 = {};
        const lds_cptr vb = (lds_cptr)(lds + R1_LV + dvb * 8192) + trbase, kb_ = (lds_cptr)(lds + (dir ? R1_LKB : R1_LKF)) + trbase;
#pragma unroll
        for (int ks = 0; ks < 8; ++ks) { const bf16x8 av = vtr8(vb + ks * 1024), b0 = vtr8(kb_ + ks * 1024), b1 = vtr8(kb_ + 8192 + ks * 1024);
            a0 = MFMA32(av, b0, a0); a1 = MFMA32(av, b1, a1); }
        LAS bf16* stg = (LAS bf16*)(lds + 65536) + wid * 2048;
#pragma unroll
        for (int r = 0; r < 16; ++r) { const int orow = crow(r, hi); stg[orow * 64 + r32] = (bf16)f2bf(a0[r]); stg[orow * 64 + 32 + r32] = (bf16)f2bf(a1[r]); }
        asm volatile("s_waitcnt lgkmcnt(0)" ::: "memory");
        bf16* gp = P.G + ((((size_t)(b * RH + h) * NC + c) * 2 + dir) * 8192) + dvb * 32 * 64;
#pragma unroll
        for (int i = 0; i < 4; ++i) *(v4u*)(gp + (i * 64 + lane) * 8) = *(const LAS v4u*)(stg + (i * 64 + lane) * 8);
    }
#undef R1_LOAD
}
constexpr int R3_CS = 2064, R3_TB = 8 * R3_CS;
constexpr int R3_KF = 0, R3_KB = R3_TB, R3_QF = 2 * R3_TB, R3_QB = 3 * R3_TB, R3_SF = 4 * R3_TB, R3_SB = 5 * R3_TB, R3_V = 6 * R3_TB, R3_GW = R3_V + 32768, R3_XCH = R3_GW + 512, R3_END = R3_XCH + 2048;
static_assert(R3_END <= LDSCTL_OFF && 8 * 4096 <= 2 * R3_TB, "R3 LDS map");
__device__ __forceinline__ void attn_ra(const Ptrs& P, int gt, int NGT);
template <int MODE> __device__ __forceinline__ void ret_out_phase(const Ptrs& P, LAS unsigned char* lds, int vcu, int G, int gt = 0, int NGT = 0) {
    const int tid = threadIdx.x, lane = tid & 63, r32 = lane & 31, hi = lane >> 5, wid = __builtin_amdgcn_readfirstlane(tid >> 6), qi = wid & 3, dvh = wid >> 2;
    const int trbase = ((lane >> 4) & 1) * 32 + (lane & 3) * 8 + (4 * hi + ((lane & 15) >> 2)) * 64;
    constexpr int NU = NB * RH * NC;
    const unsigned row0 = (unsigned)tid >> 3, chn = (unsigned)tid & 7;
    const unsigned vo_k = row0 * (RQW * 2) + chn * 16, vo_s = row0 * 128 + chn * 16, vo_v = (unsigned)(lane >> 4) * (RW * 2) + (unsigned)(lane & 15) * 16;
    const unsigned lo_k = chn * R3_CS + row0 * 16;
    v4u krv[2], qrv[2], sfv[2], sbv[2], vv[4]; f32x4 gwv = {0.f, 0.f, 0.f, 0.f}; float dsc[2][4];
#define R3_LOAD(uu) do { const int c_ = (uu) & 127, h_ = ((uu) >> 7) & 7, b_ = (uu) >> 10; const size_t t0_ = (size_t)b_ * SEQ + c_ * CH; \
        const size_t ko = t0_ * RQW + h_ * RDK; const bf16* sb_ = P.st + ((((size_t)(b_ * RH + h_) * NC + c_) * 2) * 8192); \
        _Pragma("unroll") for (int j = 0; j < 2; ++j) { \
            krv[j] = ldg16(P.kf + ko + j * 64 * RQW, vo_k); qrv[j] = ldg16(P.qf + ko + j * 64 * RQW, vo_k); \
            _Pragma("unroll") for (int kd = 0; kd < 4; ++kd) dsc[j][kd] = P.decT[kd * 1024 + h_ * 128 + row0 + 64 * j]; \
            sfv[j] = *(const v4u*)((const char*)(sb_ + j * 64 * 64) + vo_s); sbv[j] = *(const v4u*)((const char*)(sb_ + 8192 + j * 64 * 64) + vo_s); } \
        _Pragma("unroll") for (int i = 0; i < 4; ++i) vv[i] = ldg16(P.vr + (t0_ + (wid * 4 + i) * 4) * RW + h_ * RDV, vo_v); \
        if (tid < 32) gwv = *(const f32x4*)(P.gn_w + h_ * RDV + tid * 4); } while (0)
    if (vcu < NU) R3_LOAD(vcu);
    if (NGT > 0) attn_ra(P, gt, NGT);
    for (int u = vcu; u < NU; u += G) {
        const int c = u & 127, h = (u >> 7) & 7, b = u >> 10; const size_t t0 = (size_t)b * SEQ + c * CH;
        LDS_BAR();
#pragma unroll
        for (int j = 0; j < 2; ++j) { LAS unsigned char* d = lds + lo_k + j * 1024;
            *(LAS v4u*)(d + R3_QF) = scale8(qrv[j], dsc[j][0]); *(LAS v4u*)(d + R3_QB) = scale8(qrv[j], dsc[j][1]); *(LAS v4u*)(d + R3_KF) = scale8(krv[j], dsc[j][2]); *(LAS v4u*)(d + R3_KB) = scale8(krv[j], dsc[j][3]);
            *(LAS v4u*)(d + R3_SF) = sfv[j]; *(LAS v4u*)(d + R3_SB) = sbv[j]; }
#pragma unroll
        for (int i = 0; i < 4; ++i) { const int row = (wid * 4 + i) * 4 + (lane >> 4);
            *(LAS v4u*)(lds + R3_V + ((((lane & 15) >> 2) * 8 + (row >> 4)) * 1024) + (row & 15) * 64 + (lane & 3) * 16) = vv[i]; }
        if (tid < 32) ((LAS f32x4*)(lds + R3_GW))[tid] = gwv;
        LDS_BAR();
        const size_t tokb = t0 + qi * 32; const int colb = h * RDV + dvh * 64;
        v4u gv[4];
#pragma unroll
        for (int i = 0; i < 4; ++i) gv[i] = __builtin_nontemporal_load((const v4u*)(P.gr + (tokb + i * 8 + (lane >> 3)) * RW + colb + (lane & 7) * 8));
        if (u + G < NU) R3_LOAD(u + G);
        __builtin_amdgcn_sched_barrier(0);
        if (MODE == 2) { asm volatile("" :: "v"(gv[0]), "v"(gv[1]), "v"(gv[2]), "v"(gv[3])); continue; }
        const lds_cptr fb = (lds_cptr)lds + hi * R3_CS + r32 * 16;
        bf16x8 qff[4], qbf[4];
#pragma unroll
        for (int d0 = 0; d0 < 4; ++d0) { qff[d0] = *(const LAS bf16x8*)(fb + R3_QF + d0 * 2 * R3_CS + qi * 512); qbf[d0] = *(const LAS bf16x8*)(fb + R3_QB + d0 * 2 * R3_CS + qi * 512); }
        f32x16 o[2];
        o[0] = (f32x16){}; o[1] = (f32x16){};
#pragma unroll
        for (int dp = 0; dp < 2; ++dp) {
            bf16x8 sr[8];
#pragma unroll
            for (int dd = 0; dd < 2; ++dd)
#pragma unroll
                for (int dbl = 0; dbl < 2; ++dbl) { const int ro = (dvh * 2 + dbl) * 512 + (dp * 2 + dd) * 2 * R3_CS;
                    sr[dd * 4 + dbl * 2] = *(const LAS bf16x8*)(fb + R3_SF + ro); sr[dd * 4 + dbl * 2 + 1] = *(const LAS bf16x8*)(fb + R3_SB + ro); }
            __builtin_amdgcn_sched_barrier(0);
#pragma unroll
            for (int dd = 0; dd < 2; ++dd) { const int d0 = dp * 2 + dd;
                o[0] = MFMA32(sr[dd * 4 + 0], qff[d0], o[0]); o[1] = MFMA32(sr[dd * 4 + 2], qff[d0], o[1]);
                o[0] = MFMA32(sr[dd * 4 + 1], qbf[d0], o[0]); o[1] = MFMA32(sr[dd * 4 + 3], qbf[d0], o[1]); }
            __builtin_amdgcn_sched_barrier(0);
        }
        const lds_cptr vb = (lds_cptr)(lds + R3_V) + trbase;
#pragma unroll
        for (int kj = 0; kj < 4; ++kj) {
            f32x16 sf = {}, sbw = {};
            if (kj <= qi) {
                bf16x8 kr_[4];
#pragma unroll
                for (int d0 = 0; d0 < 4; ++d0) kr_[d0] = *(const LAS bf16x8*)(fb + R3_KF + d0 * 2 * R3_CS + kj * 512);
                __builtin_amdgcn_sched_barrier(0);
#pragma unroll
                for (int d0 = 0; d0 < 4; ++d0) sf = MFMA32(kr_[d0], qff[d0], sf);
            }
            if (kj >= qi) {
                bf16x8 kr_[4];
#pragma unroll
                for (int d0 = 0; d0 < 4; ++d0) kr_[d0] = *(const LAS bf16x8*)(fb + R3_KB + d0 * 2 * R3_CS + kj * 512);
                __builtin_amdgcn_sched_barrier(0);
#pragma unroll
                for (int d0 = 0; d0 < 4; ++d0) sbw = MFMA32(kr_[d0], qbf[d0], sbw);
            }
            f32x16 p;
#pragma unroll
            for (int r = 0; r < 16; ++r) p[r] = (kj < qi) ? sf[r] : (kj > qi) ? sbw[r] : ((crow(r, hi) <= r32) ? sf[r] : sbw[r]);
            const bf16x8 pw0 = PK8(p, 0), pw1 = PK8(p, 8);
            bf16x8 vf_[4];
#pragma unroll
            for (int dbl = 0; dbl < 2; ++dbl) { const int db = dvh * 2 + dbl; vf_[dbl * 2] = vtr8(vb + (db * 8 + kj * 2) * 1024); vf_[dbl * 2 + 1] = vtr8(vb + (db * 8 + kj * 2 + 1) * 1024); }
            __builtin_amdgcn_sched_barrier(0);
            o[0] = MFMA32(vf_[0], pw0, o[0]); o[1] = MFMA32(vf_[2], pw0, o[1]); o[0] = MFMA32(vf_[1], pw1, o[0]); o[1] = MFMA32(vf_[3], pw1, o[1]);
        }
        float s1 = 0.f, s2 = 0.f;
#pragma unroll
        for (int dbl = 0; dbl < 2; ++dbl)
#pragma unroll
            for (int r = 0; r < 16; ++r) { s1 += o[dbl][r]; s2 += o[dbl][r] * o[dbl][r]; }
        s1 = half_swap_sum(s1); s2 = half_swap_sum(s2);
        if (MODE == 1) { asm volatile("" :: "v"(s1), "v"(s2), "v"(gv[0]), "v"(gv[1]), "v"(gv[2]), "v"(gv[3])); LDS_BAR(); continue; }
        typedef float f32x2_t __attribute__((ext_vector_type(2)));
        LAS f32x2_t* xch = (LAS f32x2_t*)(lds + R3_XCH);
        if (hi == 0) xch[wid * 32 + r32] = (f32x2_t){s1, s2};
        LDS_BAR();
        { const f32x2_t pp = xch[(wid ^ 4) * 32 + r32]; s1 += pp.x; s2 += pp.y; }
        const float mu = s1 * (1.0f / RDV), var = fmaxf(s2 * (1.0f / RDV) - mu * mu, 0.f), rs = 1.0f / sqrtf(var + EPS);
        const LAS f32x4* gw = (const LAS f32x4*)(lds + R3_GW);
        LAS unsigned char* stg = lds + wid * 4096;
#pragma unroll
        for (int dbl = 0; dbl < 2; ++dbl)
#pragma unroll
            for (int rq = 0; rq < 4; ++rq) { const int cl = dbl * 32 + 8 * rq + 4 * hi; const f32x4 w = gw[(dvh * 64 + cl) >> 2];
                u32x2 ov; ov.x = cvtpk((o[dbl][4 * rq] - mu) * rs * w.x, (o[dbl][4 * rq + 1] - mu) * rs * w.y); ov.y = cvtpk((o[dbl][4 * rq + 2] - mu) * rs * w.z, (o[dbl][4 * rq + 3] - mu) * rs * w.w);
                *(LAS u32x2*)(stg + r32 * 128 + cl * 2) = ov; }
        asm volatile("s_waitcnt lgkmcnt(0)" ::: "memory");
        v4u sv[4];
#pragma unroll
        for (int i = 0; i < 4; ++i) { const int tk = i * 8 + (lane >> 3); sv[i] = *(const LAS v4u*)(stg + tk * 128 + (lane & 7) * 16); }
#pragma unroll
        for (int i = 0; i < 4; ++i) { const int tk = i * 8 + (lane >> 3); float a[8], g8[8], y[8]; unpack8(sv[i], a); unpack8(gv[i], g8);
#pragma unroll
            for (int k = 0; k < 8; ++k) y[k] = a[k] * g8[k];
            const v4u yv = pack8(y); if (MODE == 3) asm volatile("" :: "v"(yv)); else *(v4u*)(P.mix + (tokb + tk) * DM + AW + colb + (lane & 7) * 8) = yv; }
    }
#undef R3_LOAD
}
__device__ __forceinline__ void attn_ra(const Ptrs& P, int gt, int NGT) {
    for (int t = gt; t < T; t += NGT) { const f32x4* sp = (const f32x4*)(P.ssq + (size_t)t * 16); const f32x4 a = sp[0], b = sp[1], c = sp[2], d = sp[3];
        const float ss = ((a.x + a.y) + (a.z + a.w)) + ((b.x + b.y) + (b.z + b.w)) + ((c.x + c.y) + (c.z + c.w)) + ((d.x + d.y) + (d.z + d.w));
        P.ra[t] = 1.0f / sqrtf(ss * (1.0f / AW) + EPS); }
}
__device__ __forceinline__ void ret_scan(const Ptrs& P, int gt, int NGT) {
    for (int q = gt; q < NB * RH * 2 * 4096; q += NGT) {
        const int e2 = q & 4095, dir = (q >> 12) & 1, h = (q >> 13) & 7, b = q >> 16;
        const float gam = P.gam[dir * 8 + h];
        float S0 = 0.f, S1 = 0.f;
        const size_t base = (((size_t)(b * RH + h) * NC) * 2 + dir) * 8192 + e2 * 2;
        for (int c0 = 0; c0 < NC; c0 += 32) {
            unsigned g[32];
#pragma unroll
            for (int k = 0; k < 32; ++k) { const int c = dir ? (NC - 1 - (c0 + k)) : (c0 + k); g[k] = *(const unsigned*)(P.G + base + (size_t)c * 16384); }
#pragma unroll
            for (int k = 0; k < 32; ++k) { const int c = dir ? (NC - 1 - (c0 + k)) : (c0 + k);
                *(unsigned*)(P.st + base + (size_t)c * 16384) = pk2(S0, S1);
                S0 = (S0 + bflo(g[k])) * gam; S1 = (S1 + bfhi(g[k])) * gam; }
        }
    }
}
__device__ __forceinline__ void final_norm2(const Ptrs& P, int gw, int NGW, int lane, int r0, int nrows) {
    f32x4 wv[8];
    { const GAS f32x4* wr_ = (const GAS f32x4*)P.fin_w + lane;
#pragma unroll
      for (int j = 0; j < 8; ++j) wv[j] = wr_[64 * j]; }
    for (int mr = gw; mr < nrows; mr += 2 * NGW) {
        const int m = r0 + mr, m2 = m + NGW; const bool has2 = mr + NGW < nrows; const int mb = has2 ? m2 : m;
        const GAS f32x4* xa = (const GAS f32x4*)(P.x + (size_t)m * DM) + lane; const GAS f32x4* xb = (const GAS f32x4*)(P.x + (size_t)mb * DM) + lane;
        const GAS u32x2* da = (const GAS u32x2*)(P.dlt + (size_t)m * DM) + lane; const GAS u32x2* db = (const GAS u32x2*)(P.dlt + (size_t)mb * DM) + lane;
        f32x4 va[8], vb[8]; u32x2 ea[8], eb[8];
#pragma unroll
        for (int j = 0; j < 8; ++j) { va[j] = __builtin_nontemporal_load(xa + 64 * j); vb[j] = __builtin_nontemporal_load(xb + 64 * j); ea[j] = da[64 * j]; eb[j] = db[64 * j]; }
        float sa_ = 0.f, sb_ = 0.f;
#pragma unroll
        for (int j = 0; j < 8; ++j) {
            va[j].x += bflo(ea[j].x); va[j].y += bfhi(ea[j].x); va[j].z += bflo(ea[j].y); va[j].w += bfhi(ea[j].y);
            vb[j].x += bflo(eb[j].x); vb[j].y += bfhi(eb[j].x); vb[j].z += bflo(eb[j].y); vb[j].w += bfhi(eb[j].y);
            sa_ += (va[j].x * va[j].x + va[j].y * va[j].y) + (va[j].z * va[j].z + va[j].w * va[j].w); sb_ += (vb[j].x * vb[j].x + vb[j].y * vb[j].y) + (vb[j].z * vb[j].z + vb[j].w * vb[j].w); }
        const float ra_ = 1.0f / sqrtf(wave_sum(sa_) * (1.f / DM) + EPS), rb_ = 1.0f / sqrtf(wave_sum(sb_) * (1.f / DM) + EPS);
        GAS f32x4* oa = (GAS f32x4*)(P.out + (size_t)m * DM) + lane; GAS f32x4* ob = (GAS f32x4*)(P.out + (size_t)m2 * DM) + lane;
#pragma unroll
        for (int j = 0; j < 8; ++j) { const f32x4 w = wv[j]; f32x4 o; o.x = va[j].x * ra_ * w.x; o.y = va[j].y * ra_ * w.y; o.z = va[j].z * ra_ * w.z; o.w = va[j].w * ra_ * w.w; st16_aux(P.out + (size_t)m * DM, (unsigned)(lane * 16 + j * 1024), __builtin_bit_cast(v4u, o));
            if (has2) { f32x4 o2; o2.x = vb[j].x * rb_ * w.x; o2.y = vb[j].y * rb_ * w.y; o2.z = vb[j].z * rb_ * w.z; o2.w = vb[j].w * rb_ * w.w; st16_aux(P.out + (size_t)m2 * DM, (unsigned)(lane * 16 + j * 1024), __builtin_bit_cast(v4u, o2)); } }
    }
}

#ifndef STAGGER_TICKS
#define STAGGER_TICKS 250
#endif
#ifndef MK_N_LAUNCHES
#define MK_N_LAUNCHES 1
#endif
constexpr int N_PHASES = 7;
struct Args { const float* in[11]; float* out; unsigned char* ws; int ph_lo, ph_hi; };
__device__ __forceinline__ void make_ptrs(Ptrs& P, const Args& args) {
    unsigned char* ws = args.ws;
    P.x = args.in[0]; P.norm_w = args.in[1]; P.w_in = args.in[2]; P.sink = args.in[3]; P.rel_bias = args.in[4]; P.aon_w = args.in[5];
    P.dec_f = args.in[6]; P.dec_b = args.in[7]; P.gn_w = args.in[8]; P.w_out = args.in[9]; P.fin_w = args.in[10]; P.out = args.out;
    P.win_t = (bf16*)(ws + WS_WIN); P.wo_t = (bf16*)(ws + WS_WO); P.xn = (bf16*)(ws + WS_XN); P.mix = (bf16*)(ws + WS_MIX);
    P.qa = (bf16*)(ws + WS_QA); P.ka = (bf16*)(ws + WS_KA); P.va = (bf16*)(ws + WS_VA); P.ga = (bf16*)(ws + WS_GA);
    P.qf = (bf16*)(ws + WS_QF); P.qb = (bf16*)(ws + WS_QB); P.kf = (bf16*)(ws + WS_KF); P.kb = (bf16*)(ws + WS_KB);
    P.vr = (bf16*)(ws + WS_VR); P.gr = (bf16*)(ws + WS_GR); P.st = (bf16*)(ws + WS_ST); P.dlt = (bf16*)(ws + WS_DLT);
    P.cosT = (float*)(ws + WS_COS); P.sinT = (float*)(ws + WS_SIN); P.decT = (float*)(ws + WS_DEC); P.biasT = (float*)(ws + WS_BIAS);
    P.sink2 = (float*)(ws + WS_SINK); P.gam = (float*)(ws + WS_GAM); P.ssq = (float*)(ws + WS_SSQ); P.ra = (float*)(ws + WS_SSQ + 2 * MiB); P.G = (bf16*)(ws + WS_G);

}
__global__ void __launch_bounds__(NWAVES * 64, 2) hymba_fwd(Args args) {
    extern __shared__ __attribute__((aligned(16))) unsigned char lds_raw[];
    LAS unsigned char* lds = (LAS unsigned char*)lds_raw;
    volatile LAS unsigned* MISC = (volatile LAS unsigned*)(lds + MISC_OFF);
    const int tid = threadIdx.x, lane = tid & 63, wave = __builtin_amdgcn_readfirstlane(tid >> 6);
    const int G = gridDim.x, bx = blockIdx.x, vcu = (G % 8 == 0) ? (bx % 8) * (G / 8) + bx / 8 : bx;
    const int gw = vcu * NWAVES + wave, NGW = G * NWAVES, gt = gw * 64 + lane, NGT = NGW * 64;
    unsigned char* ws = args.ws;
    gu32* ctl = (gu32*)(ws + WS_CTL);
    for (int u = tid; u < (LDS_BYTES - LDSCTL_OFF) / 4; u += NWAVES * 64) ((LAS unsigned*)(lds + LDSCTL_OFF))[u] = 0u;
    __syncthreads();
    XcdBarrier bar; bar.bar = (unsigned*)(ctl + CW_BAR); bar.x = 0; bar.st = nullptr;
    if (MK_N_LAUNCHES == 1) bar = xcd_barrier_post((unsigned*)(ctl + CW_BAR), MISC + 8);
    const int lo = args.ph_lo, hi = args.ph_hi;
#ifndef TEST_PHASES
#define TEST_PHASES 127
#endif
#define IN(k) (((TEST_PHASES >> (k)) & 1) && lo <= (k) && (k) < hi)
#define SEAM(k) do { if (IN(k) && IN((k) + 1)) xcd_barrier(bar); } while (0)
#ifndef REPEAT_MASK
#define REPEAT_MASK 0
#endif
#define NREP(k) (((REPEAT_MASK >> (k)) & 1) ? 2 : 1)

    if (IN(0)) { Ptrs P; make_ptrs(P, args); for (int rep_ = 0; rep_ < NREP(0); ++rep_) p0_prologue(P, lds, gw, NGW, wave, lane); SEAM(0); }
    if (IN(1)) for (int rep_ = 0; rep_ < NREP(1); ++rep_) { Ptrs P; make_ptrs(P, args);
        pg8::Gemm g{P.xn, P.win_t, T, INW, DM}; pg8::StaticOrder S; S.init(T, INW, G, bx);
        EpiIn E{P.qa, P.ka, P.va, P.ga, P.qf, P.qb, P.kf, P.kb, P.vr, P.gr, P.cosT, P.sinT, P.decT};
        pg8::gemm_phase<EpiIn, pg8::StaticOrder, true, true>(lds + RING_OFF, g, S, E);
        if (rep_ == NREP(1) - 1) SEAM(1);
    }
    if (IN(2)) { Ptrs P; make_ptrs(P, args); for (int rep_ = 0; rep_ < NREP(8); ++rep_) ret_kv_phase(P, lds, vcu, G); SEAM(2); }
    if (IN(3)) { Ptrs P; make_ptrs(P, args); attn_phase(P, lds, vcu, G, gt, NGT); SEAM(3); }
    if (IN(4)) { Ptrs P; make_ptrs(P, args); ret_out_phase<0>(P, lds, vcu, G, gt, NGT); if (NREP(4) > 1) ret_out_phase<0>(P, lds, vcu, G); if (NREP(11) > 1) ret_out_phase<1>(P, lds, vcu, G); if (NREP(12) > 1) ret_out_phase<2>(P, lds, vcu, G); if (NREP(13) > 1) ret_out_phase<3>(P, lds, vcu, G); SEAM(4); }
    if (IN(5)) { Ptrs P; make_ptrs(P, args);
        const bool grpA = (vcu & 1) == 0; const int nA = (G + 1) / 2, nB = G / 2, grank = vcu >> 1;
        const int gwl = grank * NWAVES + wave, ngwl = (grpA ? nA : nB) * NWAVES;
        const int rowsA = (G > 1) ? SEQ / 2 : SEQ;
        { pg8::Gemm g{P.mix, P.wo_t, SEQ, DM, DM}; pg8::StaticOrder S; S.init(SEQ, DM, G, bx); EpiDelta E{P.dlt, P.ra};
          pg8::gemm_phase<EpiDelta, pg8::StaticOrder, true, true>(lds + RING_OFF, g, S, E); }
        if (MK_N_LAUNCHES == 1) xcd_barrier(bar);
        if (grpA) final_norm2(P, gwl, ngwl, lane, 0, rowsA);
        { pg8::Gemm g{P.mix + (size_t)SEQ * DM, P.wo_t, SEQ, DM, DM}; pg8::StaticOrder S; S.init(SEQ, DM, G, bx); EpiDelta E{P.dlt + (size_t)SEQ * DM, P.ra + SEQ};
          pg8::gemm_phase<EpiDelta, pg8::StaticOrder, true, true>(lds + RING_OFF, g, S, E); }
        if (!grpA) final_norm2(P, gwl, ngwl, lane, rowsA, SEQ - rowsA);
        SEAM(5);
    }
    if (IN(6)) { Ptrs P; make_ptrs(P, args); final_norm2(P, gw, NGW, lane, SEQ, SEQ); }
#undef IN
#undef SEAM
}

extern "C" void kernel_launch(void* const* d_in, const int* in_sizes, int n_in, void* d_out, int out_size, void* d_ws, size_t ws_size, hipStream_t stream) {
    static int grid = 0;
    if (grid == 0) {
        if (n_in != 11 || in_sizes[0] != T * DM || out_size != T * DM || ws_size < WS_END) {
            fprintf(stderr, "kernel_launch: unexpected shapes: n_in %d in0 %d out %d ws %zu (need %zu)\n", n_in, n_in > 0 ? in_sizes[0] : -1, out_size, ws_size, (size_t)WS_END); grid = -1; return; }
        int dev = 0, cus = 0;
        if (hipGetDevice(&dev) != hipSuccess || hipDeviceGetAttribute(&cus, hipDeviceAttributeMultiprocessorCount, dev) != hipSuccess) { grid = -1; return; }
        if (hipFuncSetAttribute((const void*)hymba_fwd, hipFuncAttributeMaxDynamicSharedMemorySize, LDS_BYTES) != hipSuccess) { fprintf(stderr, "kernel_launch: hipFuncSetAttribute failed\n"); grid = -1; return; }
        int per_cu = 0;
        if (hipOccupancyMaxActiveBlocksPerMultiprocessor(&per_cu, (const void*)hymba_fwd, NWAVES * 64, LDS_BYTES) != hipSuccess || per_cu < 1)
            fprintf(stderr, "kernel_launch: occupancy query reports %d blocks per CU\n", per_cu);
        (void)hipGetLastError();
        grid = cus;
    }
    if (grid < 0) return;
    (void)hipMemsetAsync((char*)d_ws + WS_CTL, 0, CTL_ZERO_BYTES, stream);
    Args a{};
    for (int i = 0; i < 11; ++i) a.in[i] = (const float*)d_in[i];
    a.out = (float*)d_out; a.ws = (unsigned char*)d_ws;
    if (MK_N_LAUNCHES == 1) { a.ph_lo = 0; a.ph_hi = N_PHASES; hipLaunchKernelGGL(hymba_fwd, dim3(grid), dim3(NWAVES * 64), LDS_BYTES, stream, a); }
    else for (int li = 0; li < N_PHASES; ++li) { a.ph_lo = li; a.ph_hi = li + 1; hipLaunchKernelGGL(hymba_fwd, dim3(grid), dim3(NWAVES * 64), LDS_BYTES, stream, a); }
}
```

```cpp
#include <hip/hip_runtime.h>
#include <cstdio>
#include <cstdint>
namespace pg8 {
#define PG8_LAS __attribute__((address_space(3)))
typedef unsigned short bf16_t;
typedef short bf16x8 __attribute__((ext_vector_type(8)));
typedef float f32x4 __attribute__((ext_vector_type(4)));
typedef unsigned u32x4 __attribute__((ext_vector_type(4)));
constexpr int BM = 256, BK = 64, HALF = 128, HTB = HALF * BK * 2  , STAGE_BYTES = 8 * HTB, NXCD = 8, WGM = 8;

__host__ __device__ __forceinline__ int lds_byte(int r, int c) { const int st = (r >> 4) * 2 + (c >> 5), rr = r & 15, cc = c & 31, ob = rr * 64 + cc * 2; return st * 1024 + (ob ^ (((ob >> 9) & 1) << 5)); }
__host__ __device__ __forceinline__ void stage_rc(int b, int& R, int& C) { const int st = b / 1024, sb = b % 1024, swz = sb ^ (((sb >> 9) & 1) << 5); R = (st >> 1) * 16 + swz / 64; C = (st & 1) * 32 + (swz % 64) / 2; }
__host__ __device__ __forceinline__ int perm32(int rho) { const int n = rho >> 4, i = rho & 15; return 8 * (i >> 2) + 4 * n + (i & 3); }

struct Unit { int pm, pn; };
struct Gemm { const bf16_t* A; const bf16_t* Bt; int M, N, K; };

struct StaticOrder {
    int nM, nN, nwg, G, c;
    __host__ __device__ void init(int M, int N, int G_, int c_) { nM = M / BM; nN = N / BM; nwg = nM * nN; G = G_; c = c_; }
    __host__ __device__ bool next(int i, Unit& u) const {
        const long L = (long)i * G + c; if (L >= nwg) return false;
        int wgid = (int)L; { const int q = nwg / NXCD, r = nwg % NXCD, xcd = wgid % NXCD, off = wgid / NXCD; wgid = (xcd < r ? xcd * (q + 1) : r * (q + 1) + (xcd - r) * q) + off; }
        const int nig = WGM * nN, gid = wgid / nig, fm = gid * WGM, gsz = (nM - fm) < WGM ? (nM - fm) : WGM;
        u.pm = fm + ((wgid % nig) % gsz); u.pn = (wgid % nig) / gsz; return true;
    }
    __device__ __forceinline__ void a_ready(const Unit&) const {}
    __device__ __forceinline__ void done(const Unit&) const {}
};

__device__ __forceinline__ unsigned cvt_pk_bf16(float lo, float hi) { unsigned r; asm volatile("v_cvt_pk_bf16_f32 %0, %1, %2" : "=v"(r) : "v"(lo), "v"(hi)); return r; }
typedef float f32x2 __attribute__((ext_vector_type(2)));
template <class Epi, class Sched, bool ALIGN_EPI = false, bool SP2 = false>
__device__ __forceinline__ void gemm_phase(PG8_LAS unsigned char* lds, const Gemm g, const Sched& S, const Epi& E) {
    const int tid = threadIdx.x, wid = __builtin_amdgcn_readfirstlane(tid >> 6), lane = tid & 63, wr = wid >> 2, wc = wid & 3, fr = lane & 15, fq = lane >> 4;
    const int K = g.K, nt = K / BK;
    unsigned voffA[2], voffB[2];
#pragma unroll
    for (int i = 0; i < 2; ++i) { int R, C; stage_rc(tid * 16 + i * 8192, R, C); const int Rb = Epi::PERM ? ((R & ~31) + perm32(R & 31)) : R;
        voffA[i] = (unsigned)(R * K + C) * 2u; voffB[i] = (unsigned)(Rb * K + C) * 2u; }
    const size_t kstep = (size_t)(BK * 2);
    const size_t hstep = (size_t)HALF * K * 2;
    const size_t tstep = 2 * hstep;
    const unsigned ldsw = (unsigned)wid * 1024u;
    const int aoff = lds_byte(wr * 64 + fr, fq * 8), boff = lds_byte(wc * 32 + fr, fq * 8);
#define PG8_SA(b, h) (((b) * 2 + (h)) * HTB)
#define PG8_SB(b, h) ((4 + (b) * 2 + (h)) * HTB)
#define PG8_STAGE(bufoff, gbase, voff) do { _Pragma("unroll") for (int _i = 0; _i < 2; ++_i) \
        __builtin_amdgcn_global_load_lds((const unsigned*)((const char*)(gbase) + (voff)[_i]), (PG8_LAS unsigned*)(lds + (bufoff) + ldsw + _i * 8192), 16, 0, 0); } while (0)
#define PG8_LDA(dst, b, h) do { _Pragma("unroll") for (int m = 0; m < 4; ++m) _Pragma("unroll") for (int k = 0; k < 2; ++k) dst[m][k] = *(const PG8_LAS bf16x8*)(lds + PG8_SA(b, h) + aoff + m * 2048 + k * 1024); } while (0)
#define PG8_LDB(dst, b, h) do { _Pragma("unroll") for (int n = 0; n < 2; ++n) _Pragma("unroll") for (int k = 0; k < 2; ++k) dst[n][k] = *(const PG8_LAS bf16x8*)(lds + PG8_SB(b, h) + boff + n * 2048 + k * 1024); } while (0)
#define PG8_MMA(ai, bj, At, Bt) do { __builtin_amdgcn_s_setprio(1); _Pragma("unroll") for (int m = 0; m < 4; ++m) _Pragma("unroll") for (int n = 0; n < 2; ++n) _Pragma("unroll") for (int k = 0; k < 2; ++k) \
        acc[ai][bj][m][n] = __builtin_amdgcn_mfma_f32_16x16x32_bf16(Bt[n][k], At[m][k], acc[ai][bj][m][n], 0, 0, 0); __builtin_amdgcn_s_setprio(0); } while (0)
#define PG8_WAIT_V(n) asm volatile("s_waitcnt vmcnt(" #n ")" ::: "memory")
#define PG8_WAIT_V_SEL(f) asm volatile("v_readfirstlane_b32 vcc_lo, %0\n\ts_nop 4\n\ts_cmp_lg_u32 vcc_lo, 0\n\ts_cbranch_scc0 .Lpgw%=a\n\ts_waitcnt vmcnt(24)\n\ts_branch .Lpgw%=b\n.Lpgw%=a:\n\ts_waitcnt vmcnt(8)\n.Lpgw%=b:" :: "v"(f) : "memory", "scc", "vcc")
#define PG8_WAIT_L(n) asm volatile("s_waitcnt lgkmcnt(" #n ")" ::: "memory")
#define PG8_BAR __builtin_amdgcn_s_barrier()
#define PG8_SCHED __builtin_amdgcn_sched_barrier(0)
    Unit cur, nxt; int ui = 0;
    if (!S.next(0, cur)) return;
    f32x4 acc[2][2][4][2];
#pragma unroll
    for (int a = 0; a < 2; ++a)
#pragma unroll
        for (int b = 0; b < 2; ++b)
#pragma unroll
            for (int m = 0; m < 4; ++m)
#pragma unroll
                for (int n = 0; n < 2; ++n) acc[a][b][m][n] = (f32x4){0.f, 0.f, 0.f, 0.f};
    bf16x8 At[4][2], B0[2][2], B1[2][2];
    const char* cA = (const char*)g.A + (size_t)cur.pm * tstep; const char* cB = (const char*)g.Bt + (size_t)cur.pn * tstep;
    S.a_ready(cur);
    if constexpr (SP2) {
        PG8_STAGE(PG8_SB(0, 0), cB, voffB); PG8_STAGE(PG8_SB(0, 1), cB + hstep, voffB); PG8_STAGE(PG8_SA(0, 0), cA, voffA); PG8_STAGE(PG8_SA(0, 1), cA + hstep, voffA);
        if (wr == 1) PG8_BAR;
        PG8_WAIT_V(2); PG8_BAR;
        PG8_STAGE(PG8_SB(1, 0), cB + kstep, voffB); PG8_STAGE(PG8_SA(1, 0), cA + kstep, voffA); PG8_STAGE(PG8_SB(1, 1), cB + hstep + kstep, voffB);
        PG8_WAIT_V(6); PG8_BAR;
    } else {
        PG8_STAGE(PG8_SB(0, 0), cB, voffB); PG8_STAGE(PG8_SA(0, 0), cA, voffA); PG8_STAGE(PG8_SB(0, 1), cB + hstep, voffB); PG8_STAGE(PG8_SA(0, 1), cA + hstep, voffA);
        if (wr == 1) PG8_BAR;
        PG8_WAIT_V(4); PG8_BAR;
        PG8_STAGE(PG8_SB(1, 0), cB + kstep, voffB); PG8_STAGE(PG8_SA(1, 0), cA + kstep, voffA); PG8_STAGE(PG8_SB(1, 1), cB + hstep + kstep, voffB);
        PG8_WAIT_V(6); PG8_BAR;
    }
    for (;;) {
        const bool has_next = S.next(ui + 1, nxt);
        const char* nA = has_next ? (const char*)g.A + (size_t)nxt.pm * tstep : cA; const char* nB = has_next ? (const char*)g.Bt + (size_t)nxt.pn * tstep : cB;
        for (int t = 0; t < nt; t += 2) {
            const bool last = (t == nt - 2);
            const int rlx = (Epi::EPI_STORES >= 16 && t == 0 && ui > 0) ? 1 : 0;
            if constexpr (Epi::SCALE_AT >= 0) { if (t == Epi::SCALE_AT) E.scale(acc, cur, wr, wc, fr, fq); }
            const char* a1 = cA + (size_t)(t + 1) * kstep;
            const char* a2 = last ? nA : cA + (size_t)(t + 2) * kstep; const char* b2 = last ? nB : cB + (size_t)(t + 2) * kstep;
            const char* a3 = a2 + kstep; const char* b3 = b2 + kstep;
            if (last && has_next) S.a_ready(nxt);
            if constexpr (SP2) {
            PG8_LDB(B0, 0, 0); PG8_LDB(B1, 0, 1); PG8_SCHED; PG8_LDA(At, 0, 0); PG8_STAGE(PG8_SA(1, 1), a1 + hstep, voffA);
            PG8_WAIT_V_SEL(rlx); PG8_WAIT_L(0); PG8_BAR; PG8_MMA(0, 0, At, B0); PG8_MMA(0, 1, At, B1); PG8_BAR; PG8_SCHED;
            PG8_LDA(At, 0, 1); PG8_STAGE(PG8_SB(0, 0), b2, voffB); PG8_STAGE(PG8_SB(0, 1), b2 + hstep, voffB); PG8_STAGE(PG8_SA(0, 0), a2, voffA);
            PG8_WAIT_V_SEL(rlx); PG8_WAIT_L(0); PG8_BAR; PG8_MMA(1, 0, At, B0); PG8_MMA(1, 1, At, B1); PG8_BAR; PG8_SCHED;
            PG8_LDB(B0, 1, 0); PG8_LDB(B1, 1, 1); PG8_SCHED; PG8_LDA(At, 1, 0); PG8_STAGE(PG8_SA(0, 1), a2 + hstep, voffA);
            PG8_WAIT_V(8); PG8_WAIT_L(0); PG8_BAR; PG8_MMA(0, 0, At, B0); PG8_MMA(0, 1, At, B1); PG8_BAR; PG8_SCHED;
            PG8_LDA(At, 1, 1); PG8_STAGE(PG8_SB(1, 0), b3, voffB); PG8_STAGE(PG8_SB(1, 1), b3 + hstep, voffB); PG8_STAGE(PG8_SA(1, 0), a3, voffA);
            PG8_WAIT_V(8); PG8_WAIT_L(0); PG8_BAR; PG8_MMA(1, 0, At, B0); PG8_MMA(1, 1, At, B1); PG8_BAR; PG8_SCHED;
            } else {
            PG8_LDB(B0, 0, 0); PG8_SCHED; PG8_LDA(At, 0, 0); PG8_STAGE(PG8_SA(1, 1), a1 + hstep, voffA);
            PG8_WAIT_L(8); PG8_BAR; PG8_WAIT_L(0); PG8_MMA(0, 0, At, B0); PG8_BAR; PG8_SCHED;
            PG8_LDB(B1, 0, 1); PG8_STAGE(PG8_SB(0, 0), b2, voffB);
            PG8_BAR; PG8_WAIT_L(0); PG8_MMA(0, 1, At, B1); PG8_BAR;
            PG8_LDA(At, 0, 1); PG8_STAGE(PG8_SA(0, 0), a2, voffA);
            PG8_BAR; PG8_WAIT_L(0); PG8_MMA(1, 0, At, B0); PG8_BAR; PG8_SCHED;
            PG8_STAGE(PG8_SB(0, 1), b2 + hstep, voffB);
            PG8_WAIT_V(6); PG8_BAR; PG8_MMA(1, 1, At, B1); PG8_BAR;
            PG8_LDB(B0, 1, 0); PG8_SCHED; PG8_LDA(At, 1, 0); PG8_STAGE(PG8_SA(0, 1), a2 + hstep, voffA);
            PG8_WAIT_L(8); PG8_BAR; PG8_WAIT_L(0); PG8_MMA(0, 0, At, B0); PG8_BAR; PG8_SCHED;
            PG8_LDB(B1, 1, 1); PG8_STAGE(PG8_SB(1, 0), b3, voffB);
            PG8_BAR; PG8_WAIT_L(0); PG8_MMA(0, 1, At, B1); PG8_BAR;
            PG8_LDA(At, 1, 1); PG8_STAGE(PG8_SA(1, 0), a3, voffA);
            PG8_BAR; PG8_WAIT_L(0); PG8_MMA(1, 0, At, B0); PG8_BAR; PG8_SCHED;
            PG8_STAGE(PG8_SB(1, 1), b3 + hstep, voffB);
            PG8_WAIT_V(6); PG8_BAR; PG8_MMA(1, 1, At, B1); PG8_BAR;
            }
        }
        if constexpr (ALIGN_EPI) { if (wr == 0) PG8_BAR; }
        if constexpr (!Epi::AFTER_DRAIN) { E(acc, cur, wr, wc, fr, fq); S.done(cur); }
        if (!has_next) break;
#pragma unroll
        for (int a = 0; a < 2; ++a)
#pragma unroll
            for (int b = 0; b < 2; ++b)
#pragma unroll
                for (int m = 0; m < 4; ++m)
#pragma unroll
                    for (int n = 0; n < 2; ++n) acc[a][b][m][n] = (f32x4){0.f, 0.f, 0.f, 0.f};
        cur = nxt; cA = nA; cB = nB; ++ui;
        if constexpr (ALIGN_EPI) { if (wr == 1) PG8_BAR; }
    }
    PG8_WAIT_V(0);
    if constexpr (!ALIGN_EPI) { if (wr == 0) PG8_BAR; }
    PG8_BAR;
    if constexpr (Epi::AFTER_DRAIN) { E.fused(acc, cur, wr, wc, fr, fq, lds, wid, lane); S.done(cur); }
#undef PG8_SA
#undef PG8_SB
#undef PG8_STAGE
#undef PG8_LDA
#undef PG8_LDB
#undef PG8_MMA
#undef PG8_WAIT_V
#undef PG8_WAIT_L
#undef PG8_BAR
#undef PG8_SCHED
}
}
#define GAS __attribute__((address_space(1)))
#define LAS __attribute__((address_space(3)))
typedef unsigned short bf16;
typedef unsigned v4u __attribute__((ext_vector_type(4)));
typedef float f32x4 __attribute__((ext_vector_type(4)));
typedef short bf16x8 __attribute__((ext_vector_type(8)));
typedef GAS unsigned gu32;
typedef GAS unsigned long long gu64;
#define RLX_AGENT __ATOMIC_RELAXED, __HIP_MEMORY_SCOPE_AGENT
#define LDS_WAIT() asm volatile("s_waitcnt lgkmcnt(0)" ::: "memory")
#define VM_WAIT() asm volatile("s_waitcnt vmcnt(0)" ::: "memory")
__device__ __forceinline__ unsigned long long rt() { return __builtin_amdgcn_s_memrealtime(); }
__device__ __forceinline__ unsigned f2bf(float f) { unsigned u = __builtin_bit_cast(unsigned, f); return (u + 0x7fffu + ((u >> 16) & 1u)) >> 16; }
__device__ __forceinline__ unsigned pk2(float lo, float hi) { return f2bf(lo) | (f2bf(hi) << 16); }

constexpr int NB = 2, SEQ = 16384, T = NB * SEQ, DM = 2048, INW = 5632;
constexpr int AH = 16, AHD = 64, AW = 1024, AKW = 256;
constexpr int RH = 8, RDK = 64, RDV = 128, RQW = 512, RW = 1024, CH = 128, NC = SEQ / CH;
constexpr float EPS = 1e-6f, LOG2E = 1.4426950408889634f;
constexpr int BIAS_LD = 260;
constexpr int NWAVES = 8;

constexpr size_t MiB = 1u << 20;
constexpr size_t WS_CTL = 0, CTL_ZERO_BYTES = 32768;
constexpr size_t WS_COS = 1 * MiB, WS_SIN = 3 * MiB;
constexpr size_t WS_DEC = 5 * MiB;
constexpr size_t WS_BIAS = 5 * MiB + 65536;
constexpr size_t WS_SINK = 5 * MiB + 131072;
constexpr size_t WS_GAM = 5 * MiB + 131072 + 256;
constexpr size_t WS_WIN = 8 * MiB;
constexpr size_t WS_WO = 30 * MiB;
constexpr size_t WS_XN = 40 * MiB;
constexpr size_t WS_MIX = WS_XN;
constexpr size_t WS_QA = 168 * MiB, WS_KA = 232 * MiB, WS_VA = 248 * MiB, WS_GA = 264 * MiB;
constexpr size_t WS_QF = 328 * MiB, WS_QB = 360 * MiB, WS_KF = 392 * MiB, WS_KB = 424 * MiB, WS_VR = 456 * MiB, WS_GR = 520 * MiB;
constexpr size_t WS_SSQ = 648 * MiB;
constexpr size_t WS_G = 652 * MiB;
constexpr size_t WS_ST = 780 * MiB;
constexpr size_t WS_DLT = 848 * MiB;
constexpr size_t WS_END = 976 * MiB;
constexpr int CW_TMO = 0, CW_CODE = 1, CW_BAR = 4096;

constexpr int RING_OFF = 0, RING_BYTES = 131072;
constexpr int LDSCTL_OFF = 139264, MISC_OFF = LDSCTL_OFF + 320;
constexpr int LDS_BYTES = 147456;
#define XB_TMO      128
#define XB_XCNT(j)  (256  + 64 * (j))
#define XB_XSUB(j)  (1280 + 64 * (j))
#define XB_XGEN(j)  (2304 + 64 * (j))
#define XB_TOP      3328
#define XB_TOPGEN   3392
#define XCD_BAR_WORDS 3456
#define XB_SPIN_CAP (1u << 24)

__device__ __forceinline__ unsigned xb_ld(unsigned* p)              { return __hip_atomic_load(p, __ATOMIC_RELAXED, __HIP_MEMORY_SCOPE_AGENT); }
__device__ __forceinline__ unsigned xb_add(unsigned* p, unsigned v) { return __hip_atomic_fetch_add(p, v, __ATOMIC_RELAXED, __HIP_MEMORY_SCOPE_AGENT); }
__device__ __forceinline__ unsigned xb_xcc_id() { return (unsigned)__builtin_amdgcn_s_getreg((3 << 11) | 20) & 0xFu; }
#define XB_SPIN(cond, bar) do { unsigned _sp = 0; while (cond) { __builtin_amdgcn_s_sleep(1); \
    if ((++_sp & 255u) == 0u) { if (xb_ld(&(bar)[XB_TMO])) break; if (_sp > XB_SPIN_CAP) { atomicAdd(&(bar)[XB_TMO], 1u); break; } } } } while (0)

struct XcdBarrier {
    unsigned* bar; unsigned x;
    volatile LAS unsigned* st;
};

__device__ __forceinline__ XcdBarrier xcd_barrier_post(unsigned* bar, volatile LAS unsigned* st) {
    XcdBarrier b; b.bar = bar; b.x = xb_xcc_id(); b.st = st;
    if (threadIdx.x == 0) (void)xb_add(&bar[XB_XCNT(b.x)], 1u);
    return b;
}
__device__ __forceinline__ void xcd_barrier_complete(unsigned* bar, unsigned x, unsigned& nloc, unsigned& nx) {
    const unsigned G = gridDim.x * gridDim.y * gridDim.z;
    unsigned sum, cnt, mine, sp = 0u;
    for (;;) {
        sum = 0u; cnt = 0u; mine = 0u;
#pragma unroll
        for (unsigned j = 0; j < 16; ++j) { const unsigned c = xb_ld(&bar[XB_XCNT(j)]); sum += c; cnt += (c > 0u) ? 1u : 0u; mine = (j == x) ? c : mine; }
        if (sum == G) break;
        __builtin_amdgcn_s_sleep(1);
        if ((++sp & 255u) == 0u) { if (xb_ld(&bar[XB_TMO])) break; if (sp > XB_SPIN_CAP) { atomicAdd(&bar[XB_TMO], 1u); break; } }
    }
    nloc = mine > 0u ? mine : 1u; nx = cnt > 0u ? cnt : 1u;
}

__device__ __forceinline__ void xcd_barrier(const XcdBarrier& b) {
    asm volatile("s_waitcnt vmcnt(0)" ::: "memory");
    __syncthreads();
    if (threadIdx.x == 0) {
        unsigned* bar = b.bar;
        __builtin_amdgcn_s_waitcnt(0);
        unsigned nloc = b.st[0], nx = b.st[1];
        if (nloc == 0u) { xcd_barrier_complete(bar, b.x, nloc, nx); b.st[0] = nloc; b.st[1] = nx; }
        const unsigned old = xb_add(&bar[XB_XSUB(b.x)], 1u);
        const unsigned gen = old / nloc;
        if (old + 1u == (gen + 1u) * nloc) {
            __builtin_amdgcn_fence(__ATOMIC_RELEASE, "agent");
            asm volatile("s_waitcnt vmcnt(0)" ::: "memory");
            const unsigned og = xb_add(&bar[XB_TOP], 1u);
            const unsigned tg = og / nx;
            if (og + 1u == (tg + 1u) * nx) xb_add(&bar[XB_TOPGEN], 1u);
            else XB_SPIN(xb_ld(&bar[XB_TOPGEN]) == tg, bar);
            __builtin_amdgcn_fence(__ATOMIC_ACQUIRE, "agent");
            xb_add(&bar[XB_XGEN(b.x)], 1u);
            asm volatile("s_waitcnt vmcnt(0)" ::: "memory");
        } else {
            XB_SPIN(xb_ld(&bar[XB_XGEN(b.x)]) == gen, bar);
            __builtin_amdgcn_fence(__ATOMIC_ACQUIRE, "agent");
            asm volatile("s_waitcnt vmcnt(0)" ::: "memory");
        }
    }
    __syncthreads();
}

struct Ptrs {
    const float *x, *norm_w, *w_in, *sink, *rel_bias, *aon_w, *dec_f, *dec_b, *gn_w, *w_out, *fin_w;
    float* out;
    bf16 *win_t, *wo_t, *xn, *mix, *qa, *ka, *va, *ga, *qf, *qb, *kf, *kb, *vr, *gr, *st, *dlt;
    float *cosT, *sinT, *decT, *biasT, *sink2, *gam, *ssq, *ra; bf16* G;
};
typedef unsigned u32x2 __attribute__((ext_vector_type(2)));
__device__ __forceinline__ float bflo(unsigned w) { return __builtin_bit_cast(float, w << 16); }
__device__ __forceinline__ float bfhi(unsigned w) { return __builtin_bit_cast(float, w & 0xffff0000u); }
__device__ __forceinline__ float bf2f(bf16 h) { return __builtin_bit_cast(float, (unsigned)h << 16); }
__device__ __forceinline__ float wave_sum(float v) {
#pragma unroll
    for (int o = 1; o < 64; o <<= 1) v += __shfl_xor(v, o);
    return v;
}
__device__ __forceinline__ float wave_max(float v) {
#pragma unroll
    for (int o = 1; o < 64; o <<= 1) v = fmaxf(v, __shfl_xor(v, o));
    return v;
}
__device__ __forceinline__ float silu_f(float v) { return v * __builtin_amdgcn_rcpf(1.0f + __builtin_amdgcn_exp2f(-v * LOG2E)); }
__device__ __forceinline__ void unpack8(const v4u w, float (&f)[8]) {
    f[0] = bflo(w.x); f[1] = bfhi(w.x); f[2] = bflo(w.y); f[3] = bfhi(w.y); f[4] = bflo(w.z); f[5] = bfhi(w.z); f[6] = bflo(w.w); f[7] = bfhi(w.w);
}
__device__ __forceinline__ v4u pack8(const float (&f)[8]) {
    v4u w; w.x = pg8::cvt_pk_bf16(f[0], f[1]); w.y = pg8::cvt_pk_bf16(f[2], f[3]); w.z = pg8::cvt_pk_bf16(f[4], f[5]); w.w = pg8::cvt_pk_bf16(f[6], f[7]); return w;
}

__device__ __forceinline__ v4u scale8(const v4u w, float sc) { float f[8]; unpack8(w, f);
#pragma unroll
    for (int k = 0; k < 8; ++k) f[k] *= sc;
    return pack8(f); }

__device__ __forceinline__ void p0_transpose_item(const float* W, int K, int N, bf16* WT, LAS float* scr, int item, int lane) {
    const int nblk = N / 32, kb = item / nblk, nb = item % nblk, k0 = 64 * kb, n0 = 32 * nb;
#pragma unroll 8
    for (int i = 0; i < 32; ++i) { const int kk = 2 * i + (lane >> 5); scr[kk * 33 + (lane & 31)] = __builtin_nontemporal_load(W + (size_t)(k0 + kk) * N + n0 + (lane & 31)); }
    LDS_WAIT(); asm volatile("" ::: "memory");
    const int c = lane & 7;
#pragma unroll
    for (int j = 0; j < 4; ++j) { const int n = (lane >> 3) + 8 * j; const LAS float* s = scr + (8 * c) * 33 + n;
        v4u o; o.x = pk2(s[0 * 33], s[1 * 33]); o.y = pk2(s[2 * 33], s[3 * 33]); o.z = pk2(s[4 * 33], s[5 * 33]); o.w = pk2(s[6 * 33], s[7 * 33]);
        *(GAS v4u*)(WT + (size_t)(n0 + n) * K + k0 + 8 * c) = o; }
    LDS_WAIT(); asm volatile("" ::: "memory");
}
__device__ __forceinline__ int t5_bucket(int rel) {
    const int n = rel < 0 ? -rel : rel; int b;
    if (n < 8) b = n; else if (n < 12) b = 8; else if (n < 16) b = 9; else if (n < 23) b = 10; else if (n < 32) b = 11;
    else if (n < 46) b = 12; else if (n < 64) b = 13; else if (n < 91) b = 14; else b = 15;
    return b + (rel > 0 ? 16 : 0);
}
__device__ __forceinline__ void p0_prologue(const Ptrs& P, LAS unsigned char* lds, int gw, int NGW, int wave, int lane) {
    LAS float* scr = (LAS float*)(lds + RING_OFF + wave * 16384);
    constexpr int I_IN = (DM / 64) * (INW / 32), I_OUT = (DM / 64) * (DM / 32);
    for (int it = gw; it < I_IN + I_OUT; it += NGW) {
        if (it < I_IN) p0_transpose_item(P.w_in, DM, INW, P.win_t, scr, it, lane);
        else p0_transpose_item(P.w_out, DM, DM, P.wo_t, scr, it - I_IN, lane);
    }
    {
        f32x4 wv[8];
        { const GAS f32x4* wr_ = (const GAS f32x4*)P.norm_w + lane;
#pragma unroll
          for (int j = 0; j < 8; ++j) wv[j] = wr_[64 * j]; }
        for (int m = gw; m < T; m += 2 * NGW) {
            const int m2 = m + NGW;
            const bool has2 = m2 < T;
            const GAS f32x4* xa = (const GAS f32x4*)(P.x + (size_t)m * DM) + lane; const GAS f32x4* xb = (const GAS f32x4*)(P.x + (size_t)(has2 ? m2 : m) * DM) + lane;
            f32x4 va[8], vb[8]; float sa_ = 0.f, sb_ = 0.f;
#pragma unroll
            for (int j = 0; j < 8; ++j) { va[j] = __builtin_nontemporal_load(xa + 64 * j); vb[j] = __builtin_nontemporal_load(xb + 64 * j); }
#pragma unroll
            for (int j = 0; j < 8; ++j) { sa_ += (va[j].x * va[j].x + va[j].y * va[j].y) + (va[j].z * va[j].z + va[j].w * va[j].w); sb_ += (vb[j].x * vb[j].x + vb[j].y * vb[j].y) + (vb[j].z * vb[j].z + vb[j].w * vb[j].w); }
            const float ra = 1.0f / sqrtf(wave_sum(sa_) * (1.f / DM) + EPS), rb = 1.0f / sqrtf(wave_sum(sb_) * (1.f / DM) + EPS);
            GAS u32x2* oa = (GAS u32x2*)(P.xn + (size_t)m * DM) + lane; GAS u32x2* ob = (GAS u32x2*)(P.xn + (size_t)m2 * DM) + lane;
#pragma unroll
            for (int j = 0; j < 8; ++j) { const f32x4 w = wv[j]; u32x2 o; o.x = pk2(va[j].x * ra * w.x, va[j].y * ra * w.y); o.y = pk2(va[j].z * ra * w.z, va[j].w * ra * w.w); oa[64 * j] = o;
                if (has2) { u32x2 o2; o2.x = pk2(vb[j].x * rb * w.x, vb[j].y * rb * w.y); o2.y = pk2(vb[j].z * rb * w.z, vb[j].w * rb * w.w); ob[64 * j] = o2; } }
        }
    }
    const int gt = gw * 64 + lane, NGT = NGW * 64;
    for (int idx = gt; idx < SEQ * 32; idx += NGT) {
        const int pos = idx >> 5, j = idx & 31;
        const float inv = exp2f(-((float)(2 * j) / 64.0f) * 13.287712379549449f);
        const float ang = (float)pos * inv;
        const double rev = (double)ang * 0.15915494309189535;
        const float fr = (float)(rev - floor(rev));
        P.cosT[idx] = __builtin_amdgcn_cosf(fr); P.sinT[idx] = __builtin_amdgcn_sinf(fr);
    }
    for (int idx = gt; idx < 4 * 8 * 128; idx += NGT) {
        const int kind = idx >> 10, h = (idx >> 7) & 7, i = idx & 127;
        const float lf = -log1pf(expf(-P.dec_f[h])), lb = -log1pf(expf(-P.dec_b[h]));
        float v;
        if (kind == 0) v = expf(lf * (float)i); else if (kind == 1) v = expf(-lb * (float)i);
        else if (kind == 2) v = expf(-lf * (float)i); else v = expf(lb * (float)i);
        P.decT[idx] = v;
    }
    for (int idx = gt; idx < 16 * BIAS_LD; idx += NGT) {
        const int h = idx / BIAS_LD, r = idx % BIAS_LD;
        P.biasT[idx] = (r <= 256) ? P.rel_bias[t5_bucket(r - 128) * 16 + h] * LOG2E : 0.f;
    }
    if (gt < 16) P.sink2[gt] = P.sink[gt] * LOG2E;
    if (gt < 16) { const int h = gt & 7; const float d = (gt < 8) ? P.dec_f[h] : P.dec_b[h]; P.gam[gt] = expf(-log1pf(expf(-d)) * 128.0f); }
}

#ifndef P1_ST_AUX
#define P1_ST_AUX 18
#endif
__device__ __forceinline__ void st16_aux(void* base, unsigned byte_off, const v4u v) {
    const __amdgpu_buffer_rsrc_t r = __builtin_amdgcn_make_buffer_rsrc((void*)base, (short)0, 0x7ffffff0, 0x00020000);
    __builtin_amdgcn_raw_buffer_store_b128(v, r, byte_off, 0, P1_ST_AUX);
}
struct EpiIn {
    static constexpr bool PERM = true, AFTER_DRAIN = false; static constexpr int SCALE_AT = -1, EPI_STORES = 16;
    bf16 *qa, *ka, *va, *ga, *qf, *qb, *kf, *kb, *vr, *gr; const float *cosT, *sinT, *decT;
    __device__ __forceinline__ void operator()(const pg8::f32x4 (&acc)[2][2][4][2], const pg8::Unit& u, int wr, int wc, int fr, int fq) const {
        const int pn = u.pn, row0 = u.pm * 256 + wr * 64 + fr, cl = wc * 32 + 8 * fq;
        if (pn >= 10 && pn < 14) {
            const bool isq = pn < 12; const int csec0 = (isq ? pn - 10 : pn - 12) * 256 + cl;
            bf16* oA = isq ? qf : kf; const float ksc = isq ? 1.0f : 0.125f;
            f32x4 c4[2][4], s4[2][4];
            const int p0 = (csec0 & 63) >> 1;
#pragma unroll
            for (int ai = 0; ai < 2; ++ai)
#pragma unroll
                for (int m = 0; m < 4; ++m) { const int pos = (row0 + ai * 128 + m * 16) & (SEQ - 1); c4[ai][m] = *(const f32x4*)(cosT + pos * 32 + p0); s4[ai][m] = *(const f32x4*)(sinT + pos * 32 + p0); }
            __builtin_amdgcn_sched_barrier(0);
#pragma unroll
            for (int ai = 0; ai < 2; ++ai) {
#pragma unroll
                for (int m = 0; m < 4; ++m) { const int row = row0 + ai * 128 + m * 16;
#pragma unroll
                    for (int bj = 0; bj < 2; ++bj) { const int csec = csec0 + bj * 128;
                        const pg8::f32x4 v0 = acc[ai][bj][m][0], v1 = acc[ai][bj][m][1]; const f32x4 cc = c4[ai][m] * ksc, sn = s4[ai][m] * ksc;
                        float y[8];
                        y[0] = v0[0] * cc[0] - v0[1] * sn[0]; y[1] = v0[0] * sn[0] + v0[1] * cc[0];
                        y[2] = v0[2] * cc[1] - v0[3] * sn[1]; y[3] = v0[2] * sn[1] + v0[3] * cc[1];
                        y[4] = v1[0] * cc[2] - v1[1] * sn[2]; y[5] = v1[0] * sn[2] + v1[1] * cc[2];
                        y[6] = v1[2] * cc[3] - v1[3] * sn[3]; y[7] = v1[2] * sn[3] + v1[3] * cc[3];
                        st16_aux(oA, (unsigned)(((size_t)row * RQW + csec) * 2), pack8(y)); } }
            }
            __builtin_amdgcn_sched_barrier(0);
        } else {
            bf16* base; int ldc, col0, mode;
            if (pn < 4) { base = qa; ldc = AW; col0 = pn * 256; mode = 1; }
            else if (pn == 4) { base = ka; ldc = AKW; col0 = 0; mode = 0; }
            else if (pn == 5) { base = va; ldc = AKW; col0 = 0; mode = 0; }
            else if (pn < 10) { base = ga; ldc = AW; col0 = (pn - 6) * 256; mode = 2; }
            else if (pn < 18) { base = vr; ldc = RW; col0 = (pn - 14) * 256; mode = 0; }
            else { base = gr; ldc = RW; col0 = (pn - 18) * 256; mode = 2; }
            const float sc = (mode == 1) ? 0.125f * LOG2E : 1.0f;
#pragma unroll
            for (int ai = 0; ai < 2; ++ai)
#pragma unroll
                for (int m = 0; m < 4; ++m) { const unsigned rowoff = (unsigned)(((size_t)(row0 + ai * 128 + m * 16) * ldc + col0 + cl) * 2);
#pragma unroll
                    for (int bj = 0; bj < 2; ++bj) { const pg8::f32x4 v0 = acc[ai][bj][m][0], v1 = acc[ai][bj][m][1];
                        float y[8] = {v0[0], v0[1], v0[2], v0[3], v1[0], v1[1], v1[2], v1[3]};
                        if (mode == 2) {
#pragma unroll
                            for (int k = 0; k < 8; ++k) y[k] = silu_f(y[k]);
                        } else {
#pragma unroll
                            for (int k = 0; k < 8; ++k) y[k] *= sc;
                        }
                        st16_aux(base, rowoff + bj * 256, pack8(y)); } }
        }
    }
};


struct EpiDelta {
    static constexpr bool PERM = true, AFTER_DRAIN = false; static constexpr int SCALE_AT = AW / 64, EPI_STORES = 16;
    bf16* dl; const LAS float* ra_l; const LAS int* pm_l; int nslot;
    __device__ __forceinline__ void scale(pg8::f32x4 (&acc)[2][2][4][2], const pg8::Unit& u, int wr, int wc, int fr, int fq) const {
        int slot = 0;
        for (int s_ = 1; s_ < nslot; ++s_) if (pm_l[s_] == u.pm) slot = s_;
        const LAS float* rp = ra_l + slot * 256 + wr * 64 + fr;
#pragma unroll
        for (int ai = 0; ai < 2; ++ai)
#pragma unroll
            for (int m = 0; m < 4; ++m) { const float r = rp[ai * 128 + m * 16];
#pragma unroll
                for (int bj = 0; bj < 2; ++bj)
#pragma unroll
                    for (int n = 0; n < 2; ++n) acc[ai][bj][m][n] *= r; }
    }
    __device__ __forceinline__ void operator()(const pg8::f32x4 (&acc)[2][2][4][2], const pg8::Unit& u, int wr, int wc, int fr, int fq) const {
        const int row0 = u.pm * 256 + wr * 64 + fr, col0 = u.pn * 256 + wc * 32 + 8 * fq;
#pragma unroll
        for (int ai = 0; ai < 2; ++ai)
#pragma unroll
            for (int m = 0; m < 4; ++m) { bf16* rowp = dl + (size_t)(row0 + ai * 128 + m * 16) * DM + col0;
#pragma unroll
                for (int bj = 0; bj < 2; ++bj) { const pg8::f32x4 v0 = acc[ai][bj][m][0], v1 = acc[ai][bj][m][1];
                    const float y[8] = {v0[0], v0[1], v0[2], v0[3], v1[0], v1[1], v1[2], v1[3]};
                    *(v4u*)(rowp + bj * 128) = pack8(y);     } }
    }
};
typedef float f32x16 __attribute__((ext_vector_type(16)));
typedef short s16x4 __attribute__((ext_vector_type(4)));
typedef short v4i16_t __attribute__((ext_vector_type(4)));
typedef LAS const char* lds_cptr;
__device__ __forceinline__ int crow(int r, int hi) { return (r & 3) + 8 * (r >> 2) + 4 * hi; }
__device__ __forceinline__ s16x4 vtr(lds_cptr p) { return __builtin_bit_cast(s16x4, __builtin_amdgcn_ds_read_tr16_b64_v4i16((LAS v4i16_t*)p)); }
__device__ __forceinline__ bf16x8 vtr8(lds_cptr p) { const s16x4 lo = vtr(p), hi_ = vtr(p + 512); return (bf16x8){lo[0], lo[1], lo[2], lo[3], hi_[0], hi_[1], hi_[2], hi_[3]}; }
__device__ __forceinline__ unsigned cvtpk(float lo, float hi) { typedef float f2_t __attribute__((ext_vector_type(2))); typedef __bf16 b2_t __attribute__((ext_vector_type(2))); f2_t v = {lo, hi}; b2_t b = __builtin_convertvector(v, b2_t); return __builtin_bit_cast(unsigned, b); }
__device__ __forceinline__ void half_swap(unsigned& a, unsigned& b) { asm volatile("s_nop 1\n\tv_permlane32_swap_b32 %0, %1" : "+v"(a), "+v"(b)); }
__device__ __forceinline__ float half_swap_max(float m) { unsigned a = __builtin_bit_cast(unsigned, m), b = a; half_swap(a, b); return fmaxf(__builtin_bit_cast(float, a), __builtin_bit_cast(float, b)); }
__device__ __forceinline__ float half_swap_sum(float m) { unsigned a = __builtin_bit_cast(unsigned, m), b = a; half_swap(a, b); return __builtin_bit_cast(float, a) + __builtin_bit_cast(float, b); }
#define LDS_BAR() asm volatile("s_waitcnt lgkmcnt(0)\n\ts_barrier" ::: "memory")
__device__ __forceinline__ float amax3(float a, float b, float c) { float r; asm("v_max3_f32 %0, %1, %2, %3" : "=v"(r) : "v"(a), "v"(b), "v"(c)); return r; }
#define MFMA32(a, b, c) __builtin_amdgcn_mfma_f32_32x32x16_bf16((a), (b), (c), 0, 0, 0)
#define PK8(p, B) __builtin_bit_cast(bf16x8, (v4u){cvtpk(p[B], p[B + 1]), cvtpk(p[B + 2], p[B + 3]), cvtpk(p[B + 4], p[B + 5]), cvtpk(p[B + 6], p[B + 7])})

constexpr int A_KT = 8192, A_KCS = 1040, A_KTS = 8 * A_KCS  , A_LK = 0, A_LV = 5 * A_KTS, A_LB = A_LV + 5 * A_KT, A_LWS = A_LB + 4 * 384 * 4, A_LOST = A_LWS + 8 * 64 * 4;
static_assert(A_LOST + 8 * 4096 <= RING_BYTES, "attention LDS map");
__device__ __forceinline__ void ret_scan(const Ptrs& P, int gt, int NGT);
__device__ __forceinline__ void attn_phase(const Ptrs& P, LAS unsigned char* lds, int vcu, int G, int gt, int NGT) {
    const int tid = threadIdx.x, lane = tid & 63, r32 = lane & 31, hi = lane >> 5, wid = __builtin_amdgcn_readfirstlane(tid >> 6), g = wid >> 1, sb = wid & 1;
    int cur_hk = -1;
    LAS float* wsf = (LAS float*)(lds + A_LWS) + wid * 64;
    constexpr int NU = NB * (SEQ / 64) * 4;
    v4u kreg[5], vreg[5]; bf16x8 qn[4];
#define ATT_LOAD(uu) do { const int hk_ = (uu) & 3, qb_ = ((uu) >> 2) & 255, b_ = (uu) >> 10, q0_ = qb_ * 64, tb_ = b_ * SEQ; \
        const int tlo_ = q0_ >= 128 ? 0 : (q0_ >= 64 ? 1 : 2); int thi_ = (SEQ + 128 - q0_) / 64; if (thi_ > 5) thi_ = 5; \
        const bf16* ksrc = P.ka + (size_t)(tb_ + q0_ - 128 + 8 * wid + (lane >> 3)) * AKW + hk_ * 64 + (lane & 7) * 8; \
        const bf16* vsrc = P.va + (size_t)(tb_ + q0_ - 128 + 8 * wid + (lane >> 3)) * AKW + hk_ * 64 + (lane & 7) * 8; \
        _Pragma("unroll") for (int t = 0; t < 5; ++t) if (t >= tlo_ && t < thi_) { kreg[t] = *(const v4u*)(ksrc + (size_t)t * 64 * AKW); vreg[t] = *(const v4u*)(vsrc + (size_t)t * 64 * AKW); } \
        } while (0)
#define ATT_LOADQ(uu) do { const int hk_ = (uu) & 3, qb_ = ((uu) >> 2) & 255, b_ = (uu) >> 10, q0_ = qb_ * 64, tb_ = b_ * SEQ; \
        const bf16* qp = P.qa + (size_t)(tb_ + q0_ + sb * 32 + r32) * AW + (hk_ * 4 + g) * 64 + hi * 8; \
        _Pragma("unroll") for (int d0 = 0; d0 < 4; ++d0) qn[d0] = __builtin_nontemporal_load((const bf16x8*)(qp + d0 * 16)); } while (0)
    if (vcu < NU) { ATT_LOAD(vcu); ATT_LOADQ(vcu); }
    ret_scan(P, gt, NGT);
    for (int u = vcu; u < NU; u += G) {
        const int hk = u & 3, qb = (u >> 2) & 255, b = u >> 10;
        const int q0 = qb * 64, tb = b * SEQ, h = hk * 4 + g;
        const int tlo = q0 >= 128 ? 0 : (q0 >= 64 ? 1 : 2);
        int thi = (SEQ + 128 - q0) / 64; if (thi > 5) thi = 5;
        LDS_BAR();
        if (hk != cur_hk) {
            for (int e = tid; e < 4 * 384; e += NWAVES * 64) { const int gg = e / 384, i = e % 384, r128 = i - 63;
                ((LAS float*)(lds + A_LB))[e] = (r128 >= 0 && r128 <= 256) ? P.biasT[(hk * 4 + gg) * BIAS_LD + r128] - P.sink2[hk * 4 + gg] : -1e30f; }
            cur_hk = hk;
        }
#pragma unroll
        for (int t = 0; t < 5; ++t) if (t >= tlo && t < thi) { const int row = 8 * wid + (lane >> 3), pc = lane & 7;
            *(LAS v4u*)(lds + A_LK + t * A_KTS + pc * A_KCS + row * 16) = kreg[t];
            *(LAS v4u*)(lds + A_LV + t * A_KT + ((pc >> 2) * 4 + (row >> 4)) * 1024 + (row & 15) * 64 + (pc & 3) * 16) = vreg[t]; }
        bf16x8 qr[4];
#pragma unroll
        for (int d0 = 0; d0 < 4; ++d0) qr[d0] = qn[d0];
        const float sink = P.sink2[h];
        LDS_BAR();
        v4u gv[4];
#pragma unroll
        for (int i = 0; i < 4; ++i) gv[i] = __builtin_nontemporal_load((const v4u*)(P.ga + (size_t)(tb + q0 + sb * 32 + i * 8 + (lane >> 3)) * AW + h * 64 + (lane & 7) * 8));
        const f32x4 aw0 = *(const f32x4*)(P.aon_w + h * 64 + (lane & 7) * 8), aw1 = *(const f32x4*)(P.aon_w + h * 64 + (lane & 7) * 8 + 4);
        if (u + G < NU) ATT_LOAD(u + G);
        float moff = 0.f, l = 0.f; f32x16 o0 = {}, o1 = {}; bool shifted = false;
        unsigned btoff = (unsigned)(size_t)((const LAS float*)(lds + A_LB) + g * 384 + 63 - (sb * 32 + r32) + 4 * hi) + 256u * (unsigned)tlo;
        asm volatile("" : "+v"(btoff));
        bool guard = false;
        f32x16 p0, p1;
#define ATT_CINIT() do { const LAS float* bb = (const LAS float*)(size_t)btoff; _Pragma("unroll") for (int r = 0; r < 16; ++r) { p0[r] = bb[(r & 3) + 8 * (r >> 2)]; p1[r] = bb[32 + (r & 3) + 8 * (r >> 2)]; } } while (0)
        ATT_CINIT();
#pragma unroll 1
        for (int t = tlo; t < thi;) {
            const lds_cptr kb_ = (lds_cptr)(lds + A_LK + t * A_KTS) + hi * A_KCS + r32 * 16;
            bf16x8 kf[8];
#pragma unroll
            for (int d0 = 0; d0 < 4; ++d0) { kf[2 * d0] = *(const LAS bf16x8*)(kb_ + d0 * 2 * A_KCS); kf[2 * d0 + 1] = *(const LAS bf16x8*)(kb_ + d0 * 2 * A_KCS + 512); }
            __builtin_amdgcn_sched_barrier(0);
#pragma unroll
            for (int d0 = 0; d0 < 4; ++d0) { p0 = MFMA32(kf[2 * d0], qr[d0], p0); p1 = MFMA32(kf[2 * d0 + 1], qr[d0], p1); }
            const lds_cptr vp = (lds_cptr)(lds + A_LV + t * A_KT) + ((lane >> 4) & 1) * 32 + (lane & 3) * 8 + (4 * hi + ((lane & 15) >> 2)) * 64;
            if (shifted) {
#pragma unroll
                for (int r = 0; r < 16; ++r) { p0[r] -= moff; p1[r] -= moff; }
            }
            if (guard) {
                float rm = amax3(p0[0], p1[0], p0[1]);
#pragma unroll
                for (int r = 1; r < 15; ++r) rm = amax3(rm, p1[r], p0[r + 1]);
                rm = amax3(rm, p1[15], rm);
                rm = half_swap_max(rm);
                if (__any(rm > 0.f)) {
                    const float dl = fmaxf(rm, 0.f), f = __builtin_amdgcn_exp2f(-dl); l *= f; moff += dl; shifted = true;
                    if (hi == 0) wsf[r32] = f;
#pragma unroll
                    for (int r = 0; r < 16; ++r) { const float fr_ = wsf[crow(r, hi)]; o0[r] *= fr_; o1[r] *= fr_; p0[r] -= dl; p1[r] -= dl; }
                }
            }
            float ps = 0.f;
#pragma unroll
            for (int r = 0; r < 16; ++r) { p0[r] = __builtin_amdgcn_exp2f(p0[r]); p1[r] = __builtin_amdgcn_exp2f(p1[r]); ps += p0[r] + p1[r]; }
            if (!guard && __any(!(ps <= 0x1p64f))) { guard = true; ATT_CINIT(); continue; }
            l += ps;
            const bf16x8 pa0 = PK8(p0, 0), pa1 = PK8(p0, 8), pa2 = PK8(p1, 0), pa3 = PK8(p1, 8);
            btoff += 256u; ++t;
            __builtin_amdgcn_sched_barrier(0);
            ATT_CINIT();
            bf16x8 vb[8];
#pragma unroll
            for (int i = 0; i < 4; ++i) { vb[2 * i] = vtr8(vp + i * 1024); vb[2 * i + 1] = vtr8(vp + 4096 + i * 1024); }
            __builtin_amdgcn_sched_barrier(0);
            o0 = MFMA32(pa0, vb[0], o0); o1 = MFMA32(pa0, vb[1], o1);
            o0 = MFMA32(pa1, vb[2], o0); o1 = MFMA32(pa1, vb[3], o1);
            o0 = MFMA32(pa2, vb[4], o0); o1 = MFMA32(pa2, vb[5], o1);
            o0 = MFMA32(pa3, vb[6], o0); o1 = MFMA32(pa3, vb[7], o1);
        }
#undef ATT_CINIT
        if (u + G < NU) ATT_LOADQ(u + G);
        l = half_swap_sum(l) + __builtin_amdgcn_exp2f(-moff);
        if (hi == 0) wsf[32 + r32] = 1.0f / l;
        LAS bf16* stg = (LAS bf16*)(lds + A_LOST) + wid * 2048;
#pragma unroll
        for (int r = 0; r < 16; ++r) { const int orow = crow(r, hi); const float il = wsf[32 + orow];
            stg[orow * 64 + r32] = (bf16)f2bf(o0[r] * il); stg[orow * 64 + 32 + r32] = (bf16)f2bf(o1[r] * il); }
        asm volatile("s_waitcnt lgkmcnt(0)" ::: "memory");
        bf16* ow = P.mix + (size_t)(tb + q0 + sb * 32) * DM + h * 64;
        const float awv[8] = {aw0.x, aw0.y, aw0.z, aw0.w, aw1.x, aw1.y, aw1.z, aw1.w};
        float ssv[4];
#pragma unroll
        for (int i = 0; i < 4; ++i) { const int row = i * 8 + (lane >> 3), ch = lane & 7; const v4u v = *(const LAS v4u*)(stg + row * 64 + ch * 8);
            float a[8], g8[8], y[8]; unpack8(v, a); unpack8(gv[i], g8); float ss = 0.f;
#pragma unroll
            for (int k = 0; k < 8; ++k) { ss += a[k] * a[k]; y[k] = a[k] * awv[k] * g8[k]; }
            ss += __shfl_xor(ss, 1); ss += __shfl_xor(ss, 2); ss += __shfl_xor(ss, 4); ssv[i] = ss;
            *(v4u*)(ow + (size_t)row * DM + ch * 8) = pack8(y); }
        if ((lane & 7) == 0) {
#pragma unroll
            for (int i = 0; i < 4; ++i) P.ssq[(size_t)(tb + q0 + sb * 32 + i * 8 + (lane >> 3)) * 16 + h] = ssv[i];
        }
    }
#undef ATT_LOAD
#undef ATT_LOADQ
}
__device__ __forceinline__ v4u ldg16(const void* sbase, unsigned voff) { return __builtin_nontemporal_load((const v4u*)((const char*)sbase + voff)); }
constexpr int R1_LV = 0, R1_LKF = 32768, R1_LKB = 49152;
__device__ __forceinline__ void ret_kv_phase(const Ptrs& P, LAS unsigned char* lds, int vcu, int G) {
    const int tid = threadIdx.x, lane = tid & 63, r32 = lane & 31, hi = lane >> 5, wid = __builtin_amdgcn_readfirstlane(tid >> 6), dir = wid & 1, dvb = wid >> 1;
    const int trbase = ((lane >> 4) & 1) * 32 + (lane & 3) * 8 + (4 * hi + ((lane & 15) >> 2)) * 64;
    constexpr int NU = NB * RH * NC;
    const unsigned vrow0 = (unsigned)tid >> 4, vpc = (unsigned)tid & 15, krow0 = (unsigned)tid >> 3, kpc = (unsigned)tid & 7;
    const unsigned vo_v = vrow0 * (RW * 2) + vpc * 16, vo_k = krow0 * (RQW * 2) + kpc * 16;
    v4u vv[4], krv[2]; float dsf[2], dsb[2];
#define R1_LOAD(uu) do { const int c_ = (uu) & 127, h_ = ((uu) >> 7) & 7, b_ = (uu) >> 10; const size_t t0_ = (size_t)b_ * SEQ + c_ * CH; \
        _Pragma("unroll") for (int i = 0; i < 4; ++i) vv[i] = ldg16(P.vr + (t0_ + 32 * i) * RW + h_ * RDV, vo_v); \
        _Pragma("unroll") for (int i = 0; i < 2; ++i) { krv[i] = ldg16(P.kf + (t0_ + 64 * i) * RQW + h_ * RDK, vo_k); dsf[i] = P.decT[2 * 1024 + h_ * 128 + krow0 + 64 * i]; dsb[i] = P.decT[3 * 1024 + h_ * 128 + krow0 + 64 * i]; } } while (0)
    if (vcu < NU) R1_LOAD(vcu);
    for (int u = vcu; u < NU; u += G) {
        const int c = u & 127, h = (u >> 7) & 7, b = u >> 10;
        LDS_BAR();
#pragma unroll
        for (int i = 0; i < 4; ++i) { const int row = vrow0 + 32 * i; *(LAS v4u*)(lds + R1_LV + ((vpc >> 2) * 8 + (row >> 4)) * 1024 + (row & 15) * 64 + (vpc & 3) * 16) = vv[i]; }
#pragma unroll
        for (int i = 0; i < 2; ++i) { const int row = krow0 + 64 * i, off = ((kpc >> 2) * 8 + (row >> 4)) * 1024 + (row & 15) * 64 + (kpc & 3) * 16;
            *(LAS v4u*)(lds + R1_LKF + off) = scale8(krv[i], dsf[i]); *(LAS v4u*)(lds + R1_LKB + off) = scale8(krv[i], dsb[i]); }
        LDS_BAR();
        if (u + G < NU) R1_LOAD(u + G);
        f32x16 a0 = {}, a1 = {};
        const lds_cptr vb = (lds_cptr)(lds + R1_LV + dvb * 8192) + trbase, kb_ = (lds_cptr)(lds + (dir ? R1_LKB : R1_LKF)) + trbase;
#pragma unroll
        for (int ks = 0; ks < 8; ++ks) { const bf16x8 av = vtr8(vb + ks * 1024), b0 = vtr8(kb_ + ks * 1024), b1 = vtr8(kb_ + 8192 + ks * 1024);
            a0 = MFMA32(av, b0, a0); a1 = MFMA32(av, b1, a1); }
        LAS bf16* stg = (LAS bf16*)(lds + 65536) + wid * 2048;
#pragma unroll
        for (int r = 0; r < 16; ++r) { const int orow = crow(r, hi); stg[orow * 64 + r32] = (bf16)f2bf(a0[r]); stg[orow * 64 + 32 + r32] = (bf16)f2bf(a1[r]); }
        asm volatile("s_waitcnt lgkmcnt(0)" ::: "memory");
        bf16* gp = P.G + ((((size_t)(b * RH + h) * NC + c) * 2 + dir) * 8192) + dvb * 32 * 64;
#pragma unroll
        for (int i = 0; i < 4; ++i) *(v4u*)(gp + (i * 64 + lane) * 8) = *(const LAS v4u*)(stg + (i * 64 + lane) * 8);
    }
#undef R1_LOAD
}
constexpr int R3_CS = 2064, R3_TB = 8 * R3_CS;
constexpr int R3_KF = 0, R3_KB = R3_TB, R3_QF = 2 * R3_TB, R3_QB = 3 * R3_TB, R3_SF = 4 * R3_TB, R3_SB = 5 * R3_TB, R3_V = 6 * R3_TB, R3_GW = R3_V + 32768, R3_XCH = R3_GW + 512, R3_END = R3_XCH + 2048;
static_assert(R3_END <= LDSCTL_OFF && 8 * 4096 <= 2 * R3_TB, "R3 LDS map");
__device__ __forceinline__ void attn_ra(const Ptrs& P, int gt, int NGT);
template <int MODE> __device__ __forceinline__ void ret_out_phase(const Ptrs& P, LAS unsigned char* lds, int vcu, int G, int gt = 0, int NGT = 0) {
    const int tid = threadIdx.x, lane = tid & 63, r32 = lane & 31, hi = lane >> 5, wid = __builtin_amdgcn_readfirstlane(tid >> 6), qi = wid & 3, dvh = wid >> 2;
    const int trbase = ((lane >> 4) & 1) * 32 + (lane & 3) * 8 + (4 * hi + ((lane & 15) >> 2)) * 64;
    constexpr int NU = NB * RH * NC;
    const unsigned row0 = (unsigned)tid >> 3, chn = (unsigned)tid & 7;
    const unsigned vo_k = row0 * (RQW * 2) + chn * 16, vo_s = row0 * 128 + chn * 16, vo_v = (unsigned)(lane >> 4) * (RW * 2) + (unsigned)(lane & 15) * 16;
    const unsigned lo_k = chn * R3_CS + row0 * 16;
    v4u krv[2], qrv[2], sfv[2], sbv[2], vv[4]; f32x4 gwv = {0.f, 0.f, 0.f, 0.f}; float dsc[2][4];
#define R3_LOAD(uu) do { const int c_ = (uu) & 127, h_ = ((uu) >> 7) & 7, b_ = (uu) >> 10; const size_t t0_ = (size_t)b_ * SEQ + c_ * CH; \
        const size_t ko = t0_ * RQW + h_ * RDK; const bf16* sb_ = P.st + ((((size_t)(b_ * RH + h_) * NC + c_) * 2) * 8192); \
        _Pragma("unroll") for (int j = 0; j < 2; ++j) { \
            krv[j] = ldg16(P.kf + ko + j * 64 * RQW, vo_k); qrv[j] = ldg16(P.qf + ko + j * 64 * RQW, vo_k); \
            _Pragma("unroll") for (int kd = 0; kd < 4; ++kd) dsc[j][kd] = P.decT[kd * 1024 + h_ * 128 + row0 + 64 * j]; \
            sfv[j] = __builtin_nontemporal_load((const v4u*)((const char*)(sb_ + j * 64 * 64) + vo_s)); sbv[j] = __builtin_nontemporal_load((const v4u*)((const char*)(sb_ + 8192 + j * 64 * 64) + vo_s)); } \
        _Pragma("unroll") for (int i = 0; i < 4; ++i) vv[i] = ldg16(P.vr + (t0_ + (wid * 4 + i) * 4) * RW + h_ * RDV, vo_v); \
        if (tid < 32) gwv = *(const f32x4*)(P.gn_w + h_ * RDV + tid * 4); } while (0)
    if (vcu < NU) R3_LOAD(vcu);
    if (NGT > 0) attn_ra(P, gt, NGT);
    for (int u = vcu; u < NU; u += G) {
        const int c = u & 127, h = (u >> 7) & 7, b = u >> 10; const size_t t0 = (size_t)b * SEQ + c * CH;
        LDS_BAR();
#pragma unroll
        for (int j = 0; j < 2; ++j) { LAS unsigned char* d = lds + lo_k + j * 1024;
            *(LAS v4u*)(d + R3_QF) = scale8(qrv[j], dsc[j][0]); *(LAS v4u*)(d + R3_QB) = scale8(qrv[j], dsc[j][1]); *(LAS v4u*)(d + R3_KF) = scale8(krv[j], dsc[j][2]); *(LAS v4u*)(d + R3_KB) = scale8(krv[j], dsc[j][3]);
            *(LAS v4u*)(d + R3_SF) = sfv[j]; *(LAS v4u*)(d + R3_SB) = sbv[j]; }
#pragma unroll
        for (int i = 0; i < 4; ++i) { const int row = (wid * 4 + i) * 4 + (lane >> 4);
            *(LAS v4u*)(lds + R3_V + ((((lane & 15) >> 2) * 8 + (row >> 4)) * 1024) + (row & 15) * 64 + (lane & 3) * 16) = vv[i]; }
        if (tid < 32) ((LAS f32x4*)(lds + R3_GW))[tid] = gwv;
        LDS_BAR();
        const size_t tokb = t0 + qi * 32; const int colb = h * RDV + dvh * 64;
        v4u gv[4];
#pragma unroll
        for (int i = 0; i < 4; ++i) gv[i] = __builtin_nontemporal_load((const v4u*)(P.gr + (tokb + i * 8 + (lane >> 3)) * RW + colb + (lane & 7) * 8));
        if (u + G < NU) R3_LOAD(u + G);
        __builtin_amdgcn_sched_barrier(0);
        if (MODE == 2) { asm volatile("" :: "v"(gv[0]), "v"(gv[1]), "v"(gv[2]), "v"(gv[3])); continue; }
        const lds_cptr fb = (lds_cptr)lds + hi * R3_CS + r32 * 16;
        bf16x8 qff[4], qbf[4];
#pragma unroll
        for (int d0 = 0; d0 < 4; ++d0) { qff[d0] = *(const LAS bf16x8*)(fb + R3_QF + d0 * 2 * R3_CS + qi * 512); qbf[d0] = *(const LAS bf16x8*)(fb + R3_QB + d0 * 2 * R3_CS + qi * 512); }
        f32x16 o[2];
        o[0] = (f32x16){}; o[1] = (f32x16){};
#pragma unroll
        for (int dp = 0; dp < 2; ++dp) {
            bf16x8 sr[8];
#pragma unroll
            for (int dd = 0; dd < 2; ++dd)
#pragma unroll
                for (int dbl = 0; dbl < 2; ++dbl) { const int ro = (dvh * 2 + dbl) * 512 + (dp * 2 + dd) * 2 * R3_CS;
                    sr[dd * 4 + dbl * 2] = *(const LAS bf16x8*)(fb + R3_SF + ro); sr[dd * 4 + dbl * 2 + 1] = *(const LAS bf16x8*)(fb + R3_SB + ro); }
            __builtin_amdgcn_sched_barrier(0);
#pragma unroll
            for (int dd = 0; dd < 2; ++dd) { const int d0 = dp * 2 + dd;
                o[0] = MFMA32(sr[dd * 4 + 0], qff[d0], o[0]); o[1] = MFMA32(sr[dd * 4 + 2], qff[d0], o[1]);
                o[0] = MFMA32(sr[dd * 4 + 1], qbf[d0], o[0]); o[1] = MFMA32(sr[dd * 4 + 3], qbf[d0], o[1]); }
            __builtin_amdgcn_sched_barrier(0);
        }
        const lds_cptr vb = (lds_cptr)(lds + R3_V) + trbase;
#pragma unroll
        for (int kj = 0; kj < 4; ++kj) {
            f32x16 sf = {}, sbw = {};
            if (kj <= qi) {
                bf16x8 kr_[4];
#pragma unroll
                for (int d0 = 0; d0 < 4; ++d0) kr_[d0] = *(const LAS bf16x8*)(fb + R3_KF + d0 * 2 * R3_CS + kj * 512);
                __builtin_amdgcn_sched_barrier(0);
#pragma unroll
                for (int d0 = 0; d0 < 4; ++d0) sf = MFMA32(kr_[d0], qff[d0], sf);
            }
            if (kj >= qi) {
                bf16x8 kr_[4];
#pragma unroll
                for (int d0 = 0; d0 < 4; ++d0) kr_[d0] = *(const LAS bf16x8*)(fb + R3_KB + d0 * 2 * R3_CS + kj * 512);
                __builtin_amdgcn_sched_barrier(0);
#pragma unroll
                for (int d0 = 0; d0 < 4; ++d0) sbw = MFMA32(kr_[d0], qbf[d0], sbw);
            }
            f32x16 p;
#pragma unroll
            for (int r = 0; r < 16; ++r) p[r] = (kj < qi) ? sf[r] : (kj > qi) ? sbw[r] : ((crow(r, hi) <= r32) ? sf[r] : sbw[r]);
            const bf16x8 pw0 = PK8(p, 0), pw1 = PK8(p, 8);
            bf16x8 vf_[4];
#pragma unroll
            for (int dbl = 0; dbl < 2; ++dbl) { const int db = dvh * 2 + dbl; vf_[dbl * 2] = vtr8(vb + (db * 8 + kj * 2) * 1024); vf_[dbl * 2 + 1] = vtr8(vb + (db * 8 + kj * 2 + 1) * 1024); }
            __builtin_amdgcn_sched_barrier(0);
            o[0] = MFMA32(vf_[0], pw0, o[0]); o[1] = MFMA32(vf_[2], pw0, o[1]); o[0] = MFMA32(vf_[1], pw1, o[0]); o[1] = MFMA32(vf_[3], pw1, o[1]);
        }
        float s1 = 0.f, s2 = 0.f;
#pragma unroll
        for (int dbl = 0; dbl < 2; ++dbl)
#pragma unroll
            for (int r = 0; r < 16; ++r) { s1 += o[dbl][r]; s2 += o[dbl][r] * o[dbl][r]; }
        s1 = half_swap_sum(s1); s2 = half_swap_sum(s2);
        if (MODE == 1) { asm volatile("" :: "v"(s1), "v"(s2), "v"(gv[0]), "v"(gv[1]), "v"(gv[2]), "v"(gv[3])); LDS_BAR(); continue; }
        typedef float f32x2_t __attribute__((ext_vector_type(2)));
        LAS f32x2_t* xch = (LAS f32x2_t*)(lds + R3_XCH);
        if (hi == 0) xch[wid * 32 + r32] = (f32x2_t){s1, s2};
        LDS_BAR();
        { const f32x2_t pp = xch[(wid ^ 4) * 32 + r32]; s1 += pp.x; s2 += pp.y; }
        const float mu = s1 * (1.0f / RDV), var = fmaxf(s2 * (1.0f / RDV) - mu * mu, 0.f), rs = 1.0f / sqrtf(var + EPS);
        const LAS f32x4* gw = (const LAS f32x4*)(lds + R3_GW);
        LAS unsigned char* stg = lds + wid * 4096;
#pragma unroll
        for (int dbl = 0; dbl < 2; ++dbl)
#pragma unroll
            for (int rq = 0; rq < 4; ++rq) { const int cl = dbl * 32 + 8 * rq + 4 * hi; const f32x4 w = gw[(dvh * 64 + cl) >> 2];
                u32x2 ov; ov.x = cvtpk((o[dbl][4 * rq] - mu) * rs * w.x, (o[dbl][4 * rq + 1] - mu) * rs * w.y); ov.y = cvtpk((o[dbl][4 * rq + 2] - mu) * rs * w.z, (o[dbl][4 * rq + 3] - mu) * rs * w.w);
                *(LAS u32x2*)(stg + r32 * 128 + cl * 2) = ov; }
        asm volatile("s_waitcnt lgkmcnt(0)" ::: "memory");
        v4u sv[4];
#pragma unroll
        for (int i = 0; i < 4; ++i) { const int tk = i * 8 + (lane >> 3); sv[i] = *(const LAS v4u*)(stg + tk * 128 + (lane & 7) * 16); }
#pragma unroll
        for (int i = 0; i < 4; ++i) { const int tk = i * 8 + (lane >> 3); float a[8], g8[8], y[8]; unpack8(sv[i], a); unpack8(gv[i], g8);
#pragma unroll
            for (int k = 0; k < 8; ++k) y[k] = a[k] * g8[k];
            const v4u yv = pack8(y); if (MODE == 3) asm volatile("" :: "v"(yv)); else *(v4u*)(P.mix + (tokb + tk) * DM + AW + colb + (lane & 7) * 8) = yv; }
    }
#undef R3_LOAD
}
__device__ __forceinline__ void attn_ra(const Ptrs& P, int gt, int NGT) {
    for (int t = gt; t < T; t += NGT) { const f32x4* sp = (const f32x4*)(P.ssq + (size_t)t * 16); const f32x4 a = sp[0], b = sp[1], c = sp[2], d = sp[3];
        const float ss = ((a.x + a.y) + (a.z + a.w)) + ((b.x + b.y) + (b.z + b.w)) + ((c.x + c.y) + (c.z + c.w)) + ((d.x + d.y) + (d.z + d.w));
        P.ra[t] = 1.0f / sqrtf(ss * (1.0f / AW) + EPS); }
}
__device__ __forceinline__ void ret_scan(const Ptrs& P, int gt, int NGT) {
    for (int q = gt; q < NB * RH * 2 * 4096; q += NGT) {
        const int e2 = q & 4095, dir = (q >> 12) & 1, h = (q >> 13) & 7, b = q >> 16;
        const float gam = P.gam[dir * 8 + h];
        float S0 = 0.f, S1 = 0.f;
        const size_t base = (((size_t)(b * RH + h) * NC) * 2 + dir) * 8192 + e2 * 2;
        for (int c0 = 0; c0 < NC; c0 += 32) {
            unsigned g[32];
#pragma unroll
            for (int k = 0; k < 32; ++k) { const int c = dir ? (NC - 1 - (c0 + k)) : (c0 + k); g[k] = __builtin_nontemporal_load((const unsigned*)(P.G + base + (size_t)c * 16384)); }
#pragma unroll
            for (int k = 0; k < 32; ++k) { const int c = dir ? (NC - 1 - (c0 + k)) : (c0 + k);
                *(unsigned*)(P.st + base + (size_t)c * 16384) = pk2(S0, S1);
                S0 = (S0 + bflo(g[k])) * gam; S1 = (S1 + bfhi(g[k])) * gam; }
        }
    }
}
__device__ __forceinline__ void final_norm2(const Ptrs& P, int gw, int NGW, int lane, int r0, int nrows) {
    f32x4 wv[8];
    { const GAS f32x4* wr_ = (const GAS f32x4*)P.fin_w + lane;
#pragma unroll
      for (int j = 0; j < 8; ++j) wv[j] = wr_[64 * j]; }
    for (int mr = gw; mr < nrows; mr += 2 * NGW) {
        const int m = r0 + mr, m2 = m + NGW; const bool has2 = mr + NGW < nrows; const int mb = has2 ? m2 : m;
        const GAS f32x4* xa = (const GAS f32x4*)(P.x + (size_t)m * DM) + lane; const GAS f32x4* xb = (const GAS f32x4*)(P.x + (size_t)mb * DM) + lane;
        const GAS u32x2* da = (const GAS u32x2*)(P.dlt + (size_t)m * DM) + lane; const GAS u32x2* db = (const GAS u32x2*)(P.dlt + (size_t)mb * DM) + lane;
        f32x4 va[8], vb[8]; u32x2 ea[8], eb[8];
#pragma unroll
        for (int j = 0; j < 8; ++j) { va[j] = __builtin_nontemporal_load(xa + 64 * j); vb[j] = __builtin_nontemporal_load(xb + 64 * j); ea[j] = da[64 * j]; eb[j] = db[64 * j]; }
        float sa_ = 0.f, sb_ = 0.f;
#pragma unroll
        for (int j = 0; j < 8; ++j) {
            va[j].x += bflo(ea[j].x); va[j].y += bfhi(ea[j].x); va[j].z += bflo(ea[j].y); va[j].w += bfhi(ea[j].y);
            vb[j].x += bflo(eb[j].x); vb[j].y += bfhi(eb[j].x); vb[j].z += bflo(eb[j].y); vb[j].w += bfhi(eb[j].y);
            sa_ += (va[j].x * va[j].x + va[j].y * va[j].y) + (va[j].z * va[j].z + va[j].w * va[j].w); sb_ += (vb[j].x * vb[j].x + vb[j].y * vb[j].y) + (vb[j].z * vb[j].z + vb[j].w * vb[j].w); }
        const float ra_ = 1.0f / sqrtf(wave_sum(sa_) * (1.f / DM) + EPS), rb_ = 1.0f / sqrtf(wave_sum(sb_) * (1.f / DM) + EPS);
        GAS f32x4* oa = (GAS f32x4*)(P.out + (size_t)m * DM) + lane; GAS f32x4* ob = (GAS f32x4*)(P.out + (size_t)m2 * DM) + lane;
#pragma unroll
        for (int j = 0; j < 8; ++j) { const f32x4 w = wv[j]; f32x4 o; o.x = va[j].x * ra_ * w.x; o.y = va[j].y * ra_ * w.y; o.z = va[j].z * ra_ * w.z; o.w = va[j].w * ra_ * w.w; st16_aux(P.out + (size_t)m * DM, (unsigned)(lane * 16 + j * 1024), __builtin_bit_cast(v4u, o));
            if (has2) { f32x4 o2; o2.x = vb[j].x * rb_ * w.x; o2.y = vb[j].y * rb_ * w.y; o2.z = vb[j].z * rb_ * w.z; o2.w = vb[j].w * rb_ * w.w; st16_aux(P.out + (size_t)m2 * DM, (unsigned)(lane * 16 + j * 1024), __builtin_bit_cast(v4u, o2)); } }
    }
}

#ifndef STAGGER_TICKS
#define STAGGER_TICKS 250
#endif
#ifndef MK_N_LAUNCHES
#define MK_N_LAUNCHES 1
#endif
constexpr int N_PHASES = 7;
struct Args { const float* in[11]; float* out; unsigned char* ws; int ph_lo, ph_hi; };
__device__ __forceinline__ void make_ptrs(Ptrs& P, const Args& args) {
    unsigned char* ws = args.ws;
    P.x = args.in[0]; P.norm_w = args.in[1]; P.w_in = args.in[2]; P.sink = args.in[3]; P.rel_bias = args.in[4]; P.aon_w = args.in[5];
    P.dec_f = args.in[6]; P.dec_b = args.in[7]; P.gn_w = args.in[8]; P.w_out = args.in[9]; P.fin_w = args.in[10]; P.out = args.out;
    P.win_t = (bf16*)(ws + WS_WIN); P.wo_t = (bf16*)(ws + WS_WO); P.xn = (bf16*)(ws + WS_XN); P.mix = (bf16*)(ws + WS_MIX);
    P.qa = (bf16*)(ws + WS_QA); P.ka = (bf16*)(ws + WS_KA); P.va = (bf16*)(ws + WS_VA); P.ga = (bf16*)(ws + WS_GA);
    P.qf = (bf16*)(ws + WS_QF); P.qb = (bf16*)(ws + WS_QB); P.kf = (bf16*)(ws + WS_KF); P.kb = (bf16*)(ws + WS_KB);
    P.vr = (bf16*)(ws + WS_VR); P.gr = (bf16*)(ws + WS_GR); P.st = (bf16*)(ws + WS_ST); P.dlt = (bf16*)(ws + WS_DLT);
    P.cosT = (float*)(ws + WS_COS); P.sinT = (float*)(ws + WS_SIN); P.decT = (float*)(ws + WS_DEC); P.biasT = (float*)(ws + WS_BIAS);
    P.sink2 = (float*)(ws + WS_SINK); P.gam = (float*)(ws + WS_GAM); P.ssq = (float*)(ws + WS_SSQ); P.ra = (float*)(ws + WS_SSQ + 2 * MiB); P.G = (bf16*)(ws + WS_G);

}
__global__ void __launch_bounds__(NWAVES * 64, 2) hymba_fwd(Args args) {
    extern __shared__ __attribute__((aligned(16))) unsigned char lds_raw[];
    LAS unsigned char* lds = (LAS unsigned char*)lds_raw;
    volatile LAS unsigned* MISC = (volatile LAS unsigned*)(lds + MISC_OFF);
    const int tid = threadIdx.x, lane = tid & 63, wave = __builtin_amdgcn_readfirstlane(tid >> 6);
    const int G = gridDim.x, bx = blockIdx.x, vcu = (G % 8 == 0) ? (bx % 8) * (G / 8) + bx / 8 : bx;
    const int gw = vcu * NWAVES + wave, NGW = G * NWAVES, gt = gw * 64 + lane, NGT = NGW * 64;
    unsigned char* ws = args.ws;
    gu32* ctl = (gu32*)(ws + WS_CTL);
    for (int u = tid; u < (LDS_BYTES - LDSCTL_OFF) / 4; u += NWAVES * 64) ((LAS unsigned*)(lds + LDSCTL_OFF))[u] = 0u;
    __syncthreads();
    XcdBarrier bar; bar.bar = (unsigned*)(ctl + CW_BAR); bar.x = 0; bar.st = nullptr;
    if (MK_N_LAUNCHES == 1) bar = xcd_barrier_post((unsigned*)(ctl + CW_BAR), MISC + 8);
    const int lo = args.ph_lo, hi = args.ph_hi;
#ifndef TEST_PHASES
#define TEST_PHASES 127
#endif
#define IN(k) (((TEST_PHASES >> (k)) & 1) && lo <= (k) && (k) < hi)
#define SEAM(k) do { if (IN(k) && IN((k) + 1)) xcd_barrier(bar); } while (0)
#ifndef REPEAT_MASK
#define REPEAT_MASK 0
#endif
#define NREP(k) (((REPEAT_MASK >> (k)) & 1) ? 2 : 1)

    if (IN(0)) { Ptrs P; make_ptrs(P, args); for (int rep_ = 0; rep_ < NREP(0); ++rep_) p0_prologue(P, lds, gw, NGW, wave, lane); SEAM(0); }
    if (IN(1)) for (int rep_ = 0; rep_ < NREP(1); ++rep_) { Ptrs P; make_ptrs(P, args);
        pg8::Gemm g{P.xn, P.win_t, T, INW, DM}; pg8::StaticOrder S; S.init(T, INW, G, bx);
        EpiIn E{P.qa, P.ka, P.va, P.ga, P.qf, P.qb, P.kf, P.kb, P.vr, P.gr, P.cosT, P.sinT, P.decT};
        pg8::gemm_phase<EpiIn, pg8::StaticOrder, true, true>(lds + RING_OFF, g, S, E);
        if (rep_ == NREP(1) - 1) SEAM(1);
    }
    if (IN(2)) { Ptrs P; make_ptrs(P, args); for (int rep_ = 0; rep_ < NREP(8); ++rep_) ret_kv_phase(P, lds, vcu, G); SEAM(2); }
    if (IN(3)) { Ptrs P; make_ptrs(P, args); attn_phase(P, lds, vcu, G, gt, NGT); SEAM(3); }
    if (IN(4)) { Ptrs P; make_ptrs(P, args); ret_out_phase<0>(P, lds, vcu, G, gt, NGT); if (NREP(4) > 1) ret_out_phase<0>(P, lds, vcu, G); if (NREP(11) > 1) ret_out_phase<1>(P, lds, vcu, G); if (NREP(12) > 1) ret_out_phase<2>(P, lds, vcu, G); if (NREP(13) > 1) ret_out_phase<3>(P, lds, vcu, G); SEAM(4); }
    if (IN(5)) { Ptrs P; make_ptrs(P, args);
        const bool grpA = (vcu & 1) == 0; const int nA = (G + 1) / 2, nB = G / 2, grank = vcu >> 1;
        const int gwl = grank * NWAVES + wave, ngwl = (grpA ? nA : nB) * NWAVES;
        const int rowsA = (G > 1) ? SEQ / 2 : SEQ;
        constexpr int RA_SLOTS = 7; LAS float* ra_l = (LAS float*)(lds + RING_OFF + RING_BYTES); LAS int* pm_l = (LAS int*)(lds + RING_OFF + RING_BYTES + RA_SLOTS * 1024);
        static_assert(RING_OFF + RING_BYTES + RA_SLOTS * 1024 + 64 <= LDSCTL_OFF, "ra table");
#define P5_RA_TABLE(S_, rab_) int nslot = 0; { pg8::Unit uu; for (int i = 0; S_.next(i, uu) && nslot < RA_SLOTS; ++i, ++nslot) { if (tid < 256) ra_l[nslot * 256 + tid] = (rab_)[uu.pm * 256 + tid]; if (tid == 0) pm_l[nslot] = uu.pm; } } \
          __syncthreads();
        { pg8::Gemm g{P.mix, P.wo_t, SEQ, DM, DM}; pg8::StaticOrder S; S.init(SEQ, DM, G, bx); P5_RA_TABLE(S, P.ra) EpiDelta E{P.dlt, ra_l, pm_l, nslot};
          pg8::gemm_phase<EpiDelta, pg8::StaticOrder, true, true>(lds + RING_OFF, g, S, E); }
        if (MK_N_LAUNCHES == 1) xcd_barrier(bar);
        if (grpA) final_norm2(P, gwl, ngwl, lane, 0, rowsA);
        { pg8::Gemm g{P.mix + (size_t)SEQ * DM, P.wo_t, SEQ, DM, DM}; pg8::StaticOrder S; S.init(SEQ, DM, G, bx); __syncthreads(); P5_RA_TABLE(S, P.ra + SEQ) EpiDelta E{P.dlt + (size_t)SEQ * DM, ra_l, pm_l, nslot};
          pg8::gemm_phase<EpiDelta, pg8::StaticOrder, true, true>(lds + RING_OFF, g, S, E); }
#undef P5_RA_TABLE
        if (!grpA) final_norm2(P, gwl, ngwl, lane, rowsA, SEQ - rowsA);
        SEAM(5);
    }
    if (IN(6)) { Ptrs P; make_ptrs(P, args); final_norm2(P, gw, NGW, lane, SEQ, SEQ); }
#undef IN
#undef SEAM
}

extern "C" void kernel_launch(void* const* d_in, const int* in_sizes, int n_in, void* d_out, int out_size, void* d_ws, size_t ws_size, hipStream_t stream) {
    static int grid = 0;
    if (grid == 0) {
        if (n_in != 11 || in_sizes[0] != T * DM || out_size != T * DM || ws_size < WS_END) {
            fprintf(stderr, "kernel_launch: unexpected shapes: n_in %d in0 %d out %d ws %zu (need %zu)\n", n_in, n_in > 0 ? in_sizes[0] : -1, out_size, ws_size, (size_t)WS_END); grid = -1; return; }
        int dev = 0, cus = 0;
        if (hipGetDevice(&dev) != hipSuccess || hipDeviceGetAttribute(&cus, hipDeviceAttributeMultiprocessorCount, dev) != hipSuccess) { grid = -1; return; }
        if (hipFuncSetAttribute((const void*)hymba_fwd, hipFuncAttributeMaxDynamicSharedMemorySize, LDS_BYTES) != hipSuccess) { fprintf(stderr, "kernel_launch: hipFuncSetAttribute failed\n"); grid = -1; return; }
        int per_cu = 0;
        if (hipOccupancyMaxActiveBlocksPerMultiprocessor(&per_cu, (const void*)hymba_fwd, NWAVES * 64, LDS_BYTES) != hipSuccess || per_cu < 1)
            fprintf(stderr, "kernel_launch: occupancy query reports %d blocks per CU\n", per_cu);
        (void)hipGetLastError();
        grid = cus;
        if ((SEQ / 256) * (DM / 256) > 7 * grid) { fprintf(stderr, "kernel_launch: %d CUs: the out-projection's per-CU row-scale table (7 units per CU and batch element) is too small\n", grid); grid = -1; return; }
    }
    if (grid < 0) return;
    (void)hipMemsetAsync((char*)d_ws + WS_CTL, 0, CTL_ZERO_BYTES, stream);
    Args a{};
    for (int i = 0; i < 11; ++i) a.in[i] = (const float*)d_in[i];
    a.out = (float*)d_out; a.ws = (unsigned char*)d_ws;
    if (MK_N_LAUNCHES == 1) { a.ph_lo = 0; a.ph_hi = N_PHASES; hipLaunchKernelGGL(hymba_fwd, dim3(grid), dim3(NWAVES * 64), LDS_BYTES, stream, a); }
    else for (int li = 0; li < N_PHASES; ++li) { a.ph_lo = li; a.ph_hi = li + 1; hipLaunchKernelGGL(hymba_fwd, dim3(grid), dim3(NWAVES * 64), LDS_BYTES, stream, a); }
}
```
